# Optimizing an MI355X kernel written in HIP

```python
import jax, jax.numpy as jnp
from jax import lax
import numpy as np

D_MODEL = 2048
BATCH = 32
SEQ = 256
DEPTH = 1
DEC_BATCH = 2
DEC_SEQ = 4096
PAST_LEN = 512

GRID_W = 64
NA_HEADS = 8
NA_HEAD_DIM = 128
NA_WIN_ROWS = 8
NA_WIN_COLS = 16
MLA_HEADS = 8
MLA_NOPE_DIM = 128
MLA_ROPE_DIM = 64
MLA_V_DIM = 128
Q_LORA = 512
KV_LORA = 512
NA_WIDTH = NA_HEADS * NA_HEAD_DIM
MLA_WIDTH = MLA_HEADS * MLA_V_DIM
MIX_WIDTH = NA_WIDTH + MLA_WIDTH
IN_COLS = 3 * NA_WIDTH + Q_LORA + KV_LORA + MLA_ROPE_DIM
D_FF = -(-8 * D_MODEL // (3 * 256)) * 256
ROPE_THETA = 10000.0
LN_EPS = 1e-5
RMS_EPS = 1e-6
ALPHA = (2.0 * DEPTH) ** 0.25
BETA = (8.0 * DEPTH) ** -0.25
Q_BLOCK = 128
NA_SCALE = NA_HEAD_DIM ** -0.5
MLA_SCALE = (MLA_NOPE_DIM + MLA_ROPE_DIM) ** -0.5

kernel_name = "hybrid_natten_mla_dit_step"


def _layernorm(x, g, b):
    xf = x.astype(jnp.float32)
    mu = xf.mean(-1, keepdims=True)
    var = jnp.square(xf - mu).mean(-1, keepdims=True)
    return ((xf - mu) * lax.rsqrt(var + LN_EPS) * g.astype(jnp.float32) + b.astype(jnp.float32)).astype(x.dtype)


def _rmsnorm(x, g):
    xf = x.astype(jnp.float32)
    return (xf * lax.rsqrt(jnp.mean(xf * xf, -1, keepdims=True) + RMS_EPS) * g.astype(jnp.float32)).astype(x.dtype)


def _modulation(cond, w_mod, b_mod):
    m = jax.nn.silu(cond) @ w_mod + b_mod
    return jnp.split(m[..., None, :], 6, axis=-1)


def _rope_2d(x):
    n = x.shape[1]
    t = jnp.arange(n, dtype=jnp.int32)
    half = MLA_ROPE_DIM // 2
    inv_freq = ROPE_THETA ** (-jnp.arange(0, half, 2, dtype=jnp.float32) / half)

    def rot(xa, pos):
        ang = pos.astype(jnp.float32)[:, None] * inv_freq
        cos = jnp.concatenate([jnp.cos(ang)] * 2, -1)[None, :, None, :]
        sin = jnp.concatenate([jnp.sin(ang)] * 2, -1)[None, :, None, :]
        x1, x2 = jnp.split(xa, 2, -1)
        return xa * cos + jnp.concatenate([-x2, x1], -1) * sin

    xf = x.astype(jnp.float32)
    xr = rot(xf[..., :half], t // GRID_W)
    xc = rot(xf[..., half:], t % GRID_W)
    return jnp.concatenate([xr, xc], -1).astype(x.dtype)


def _project(h, w_in, q_a_g, kv_a_g, w_q_b):
    B, N, _ = h.shape
    z = h @ w_in
    s0 = 3 * NA_WIDTH
    na_qkv, q_lat, kv_lat, k_rope = jnp.split(z, [s0, s0 + Q_LORA, s0 + Q_LORA + KV_LORA], axis=-1)
    na_q, na_k, na_v = [t.reshape(B, N, NA_HEADS, NA_HEAD_DIM) for t in jnp.split(na_qkv, 3, axis=-1)]
    q = (_rmsnorm(q_lat, q_a_g) @ w_q_b).reshape(B, N, MLA_HEADS, MLA_NOPE_DIM + MLA_ROPE_DIM)
    q_nope, q_rope = q[..., :MLA_NOPE_DIM], q[..., MLA_NOPE_DIM:]
    c_kv = _rmsnorm(kv_lat, kv_a_g)
    return na_q, na_k, na_v, q_nope, q_rope, c_kv, k_rope


def _mla_expand(c_kv, w_kv_b):
    B, N, _ = c_kv.shape
    kv = (c_kv @ w_kv_b).reshape(B, N, MLA_HEADS, MLA_NOPE_DIM + MLA_V_DIM)
    return kv[..., :MLA_NOPE_DIM], kv[..., MLA_NOPE_DIM:]


def _attend(q, k, v, scale):
    B, Nq, H, dk = q.shape
    nb = Nq // Q_BLOCK
    qb = q.reshape(B, nb, Q_BLOCK, H, dk).transpose(1, 0, 2, 3, 4)

    def one(qblk):
        s = jnp.einsum('bqhd,bkhd->bhqk', qblk, k).astype(jnp.float32) * scale
        p = jax.nn.softmax(s, axis=-1).astype(v.dtype)
        return jnp.einsum('bhqk,bkhd->bqhd', p, v)

    o = lax.map(one, qb)
    return o.transpose(1, 0, 2, 3, 4).reshape(B, Nq, H, v.shape[-1])


def _neighbourhood_attention(q, k, v, k_ctx, v_ctx, rpb):
    B, N, H, d = q.shape
    rows = N // GRID_W
    wr = min(NA_WIN_ROWS, rows)
    r = jnp.arange(rows)
    rs = jnp.clip(r - wr // 2, 0, rows - wr)
    key_rows = rs[:, None] + jnp.arange(wr)[None, :]
    col = jnp.arange(GRID_W)
    cs = jnp.clip(col - NA_WIN_COLS // 2, 0, GRID_W - NA_WIN_COLS)
    in_win = (col[None, :] >= cs[:, None]) & (col[None, :] < cs[:, None] + NA_WIN_COLS)
    dr = key_rows - r[:, None] + NA_WIN_ROWS - 1
    dc = jnp.clip(col[None, :] - col[:, None] + NA_WIN_COLS - 1, 0, 2 * NA_WIN_COLS - 2)
    bias = rpb[:, dr[:, None, :, None], dc[None, :, None, :]].astype(jnp.float32)

    qg = q.reshape(B, rows, GRID_W, H, d)
    kg = k.reshape(B, rows, GRID_W, H, d)[:, key_rows]
    vg = v.reshape(B, rows, GRID_W, H, d)[:, key_rows]
    s_loc = jnp.einsum('brqhd,brwkhd->bhrqwk', qg, kg).astype(jnp.float32) * NA_SCALE + bias
    s_loc = jnp.where(in_win[:, None, :], s_loc, -jnp.inf)
    s_ctx = jnp.einsum('brqhd,blhd->bhrql', qg, k_ctx).astype(jnp.float32) * NA_SCALE
    nloc = wr * GRID_W
    s = jnp.concatenate([s_loc.reshape(B, H, rows, GRID_W, nloc), s_ctx], axis=-1)
    p = jax.nn.softmax(s, axis=-1).astype(v.dtype)
    p_loc = p[..., :nloc].reshape(B, H, rows, GRID_W, wr, GRID_W)
    p_ctx = p[..., nloc:]
    o = jnp.einsum('bhrqwk,brwkhd->brqhd', p_loc, vg) + jnp.einsum('bhrql,blhd->brqhd', p_ctx, v_ctx)
    return o.reshape(B, N, H, d)


def _merge_and_ffn(x, o_na, o_mla, mod, w_o, ln1_g, ln1_b, w_gu, w_down, ln2_g, ln2_b):
    sh1, sc1, g1, sh2, sc2, g2 = mod
    B, N = x.shape[:2]
    o = jnp.concatenate([o_na.reshape(B, N, NA_WIDTH), o_mla.reshape(B, N, MLA_WIDTH)], axis=-1) @ w_o
    x = _layernorm(ALPHA * x + g1 * o, ln1_g, ln1_b)
    h = x * (1 + sc2) + sh2
    gate, up = jnp.split(h @ w_gu, 2, axis=-1)
    f = (jax.nn.silu(gate) * up) @ w_down
    return _layernorm(ALPHA * x + g2 * f, ln2_g, ln2_b)


def _context_layer(x, mod, w_in, q_a_g, kv_a_g, w_q_b, w_kv_b, w_o, ln1_g, ln1_b, w_gu, w_down, ln2_g, ln2_b):
    sh1, sc1 = mod[0], mod[1]
    h = x * (1 + sc1) + sh1
    na_q, na_k, na_v, q_nope, q_rope, c_kv, k_rope = _project(h, w_in, q_a_g, kv_a_g, w_q_b)
    o_na = _attend(na_q, na_k, na_v, NA_SCALE)
    k_nope, v_m = _mla_expand(c_kv, w_kv_b)
    B, L = x.shape[:2]
    q_m = jnp.concatenate([q_nope, q_rope], axis=-1)
    k_m = jnp.concatenate([k_nope, jnp.broadcast_to(k_rope[:, :, None, :], (B, L, MLA_HEADS, MLA_ROPE_DIM))], axis=-1)
    o_mla = _attend(q_m, k_m, v_m, MLA_SCALE)
    y = _merge_and_ffn(x, o_na, o_mla, mod, w_o, ln1_g, ln1_b, w_gu, w_down, ln2_g, ln2_b)
    return y, na_k, na_v, c_kv, k_rope


def _latent_layer(x, mod, ck, cv, cckv, ckrope, w_in, q_a_g, kv_a_g, w_q_b, w_kv_b, rpb, w_o,
                  ln1_g, ln1_b, w_gu, w_down, ln2_g, ln2_b):
    sh1, sc1 = mod[0], mod[1]
    h = x * (1 + sc1) + sh1
    na_q, na_k, na_v, q_nope, q_rope, c_kv, k_rope = _project(h, w_in, q_a_g, kv_a_g, w_q_b)
    o_na = _neighbourhood_attention(na_q, na_k, na_v, ck, cv, rpb)
    B, N = x.shape[:2]
    L = cckv.shape[1]
    k_nope, v_lat = _mla_expand(c_kv, w_kv_b)
    k_nope_ctx, v_ctx = _mla_expand(cckv, w_kv_b)
    q_m = jnp.concatenate([q_nope, _rope_2d(q_rope)], axis=-1)
    k_rope_lat = jnp.broadcast_to(_rope_2d(k_rope[:, :, None, :]), (B, N, MLA_HEADS, MLA_ROPE_DIM))
    k_rope_ctx = jnp.broadcast_to(ckrope[:, :, None, :], (B, L, MLA_HEADS, MLA_ROPE_DIM))
    k_m = jnp.concatenate([jnp.concatenate([k_nope, k_rope_lat], -1),
                           jnp.concatenate([k_nope_ctx, k_rope_ctx], -1)], axis=1)
    v_m = jnp.concatenate([v_lat, v_ctx], axis=1)
    o_mla = _attend(q_m, k_m, v_m, MLA_SCALE)
    return _merge_and_ffn(x, o_na, o_mla, mod, w_o, ln1_g, ln1_b, w_gu, w_down, ln2_g, ln2_b)


def setup_inputs(seed: int = 0) -> dict:
    key = jax.random.key(seed)
    ks = jax.random.split(key, 32)
    nrm = lambda k, shape, s: jax.random.normal(k, shape, jnp.float32) * s
    return {
        "x_prompt": nrm(ks[0], (BATCH, SEQ, D_MODEL), 1.0),
        "x_sample": nrm(ks[1], (DEC_BATCH, DEC_SEQ, D_MODEL), 1.0),
        "cache_na_k": nrm(ks[2], (DEC_BATCH, DEPTH, PAST_LEN, NA_HEADS, NA_HEAD_DIM), 1.0),
        "cache_na_v": nrm(ks[3], (DEC_BATCH, DEPTH, PAST_LEN, NA_HEADS, NA_HEAD_DIM), 1.0),
        "cache_mla_ckv": nrm(ks[4], (DEC_BATCH, DEPTH, PAST_LEN, KV_LORA), 1.0),
        "cache_mla_krope": nrm(ks[5], (DEC_BATCH, DEPTH, PAST_LEN, MLA_ROPE_DIM), 1.0),
        "c": nrm(ks[6], (DEC_BATCH, D_MODEL), 1.0),
        "c_ctx": nrm(ks[7], (D_MODEL,), 1.0),
        "w_mod": nrm(ks[8], (DEPTH, D_MODEL, 6 * D_MODEL), 0.5 * D_MODEL ** -0.5),
        "b_mod": nrm(ks[9], (DEPTH, 6 * D_MODEL), 0.02),
        "w_in": nrm(ks[10], (DEPTH, D_MODEL, IN_COLS), D_MODEL ** -0.5),
        "q_a_norm": 1.0 + nrm(ks[11], (DEPTH, Q_LORA), 0.02),
        "kv_a_norm": 1.0 + nrm(ks[12], (DEPTH, KV_LORA), 0.02),
        "w_q_b": nrm(ks[13], (DEPTH, Q_LORA, MLA_HEADS * (MLA_NOPE_DIM + MLA_ROPE_DIM)), Q_LORA ** -0.5),
        "w_kv_b": nrm(ks[14], (DEPTH, KV_LORA, MLA_HEADS * (MLA_NOPE_DIM + MLA_V_DIM)), KV_LORA ** -0.5),
        "na_rpb": nrm(ks[15], (DEPTH, NA_HEADS, 2 * NA_WIN_ROWS - 1, 2 * NA_WIN_COLS - 1), 0.1),
        "w_o": nrm(ks[16], (DEPTH, MIX_WIDTH, D_MODEL), BETA * MIX_WIDTH ** -0.5),
        "ln1_g": 1.0 + nrm(ks[17], (DEPTH, D_MODEL), 0.02),
        "ln1_b": nrm(ks[18], (DEPTH, D_MODEL), 0.02),
        "w_gu": nrm(ks[19], (DEPTH, D_MODEL, 2 * D_FF), D_MODEL ** -0.5),
        "w_down": nrm(ks[20], (DEPTH, D_FF, D_MODEL), BETA * D_FF ** -0.5),
        "ln2_g": 1.0 + nrm(ks[21], (DEPTH, D_MODEL), 0.02),
        "ln2_b": nrm(ks[22], (DEPTH, D_MODEL), 0.02),
    }


def reference(x_prompt, x_sample, cache_na_k, cache_na_v, cache_mla_ckv, cache_mla_krope, c, c_ctx,
              w_mod, b_mod, w_in, q_a_norm, kv_a_norm, w_q_b, w_kv_b, na_rpb, w_o,
              ln1_g, ln1_b, w_gu, w_down, ln2_g, ln2_b):
    xp = x_prompt
    nk, nv, nckv, nkr = [], [], [], []
    for l in range(DEPTH):
        mod_ctx = _modulation(c_ctx, w_mod[l], b_mod[l])
        xp, k_l, v_l, ckv_l, kr_l = _context_layer(
            xp, mod_ctx, w_in[l], q_a_norm[l], kv_a_norm[l], w_q_b[l], w_kv_b[l], w_o[l],
            ln1_g[l], ln1_b[l], w_gu[l], w_down[l], ln2_g[l], ln2_b[l])
        nk.append(k_l)
        nv.append(v_l)
        nckv.append(ckv_l)
        nkr.append(kr_l)
    state_na_k = jnp.stack(nk, axis=1)
    state_na_v = jnp.stack(nv, axis=1)
    state_mla_ckv = jnp.stack(nckv, axis=1)
    state_mla_krope = jnp.stack(nkr, axis=1)

    xs = x_sample
    for l in range(DEPTH):
        mod_lat = _modulation(c, w_mod[l], b_mod[l])
        xs = _latent_layer(
            xs, mod_lat, cache_na_k[:, l], cache_na_v[:, l], cache_mla_ckv[:, l], cache_mla_krope[:, l],
            w_in[l], q_a_norm[l], kv_a_norm[l], w_q_b[l], w_kv_b[l], na_rpb[l], w_o[l],
            ln1_g[l], ln1_b[l], w_gu[l], w_down[l], ln2_g[l], ln2_b[l])

    return (xp, xs, state_na_k, state_na_v, state_mla_ckv, state_mla_krope)
```

```cpp
#include <hip/hip_runtime.h>
#include <hip/hip_cooperative_groups.h>
#include <cstdio>
#include <cstdint>
namespace cg = cooperative_groups;

#ifndef PROBE_DUP
#define PROBE_DUP -1
#endif
#ifndef MK_MULTI
#define MK_MULTI 0
#endif

typedef unsigned short bf16_t;
typedef short bf16x8 __attribute__((ext_vector_type(8)));
typedef short s16x4 __attribute__((ext_vector_type(4)));
typedef float f32x4 __attribute__((ext_vector_type(4)));
typedef float f32x16 __attribute__((ext_vector_type(16)));
typedef unsigned u32x4 __attribute__((ext_vector_type(4)));
typedef unsigned u32x2 __attribute__((ext_vector_type(2)));
#define LAS __attribute__((address_space(3)))

constexpr int DM = 2048, NCTX = 8192, MTOK = 16384, INC = 4160, INCP = 4352, DFF = 5632, NMOD = 12288;
constexpr int ZQ = 0, ZK = 1024, ZV = 2048, ZQL = 3072, ZKVL = 3584, ZKR = 4096;
constexpr float ALPHA = 1.189207115002721f;
constexpr float LN_EPS = 1e-5f, RMS_EPS = 1e-6f;
constexpr int NTHREADS = 512, NWAVES = 8;
constexpr int LDS_BYTES = 147456;

constexpr size_t MiB = 1u << 20;
constexpr size_t KiB = 1u << 10;
constexpr size_t OFF_MOD = 6 * MiB + 512 * KiB + 32 * KiB;
constexpr size_t OFF_CNK = 256 * KiB;
constexpr size_t OFF_CNV = OFF_CNK + 2 * MiB;
constexpr size_t OFF_CCKV = OFF_CNV + 2 * MiB;
constexpr size_t OFF_KRL = OFF_CCKV + 1 * MiB;
constexpr size_t OFF_BAR = 6 * MiB + 512 * KiB;
constexpr size_t OFF_WIN = 7 * MiB;
constexpr size_t OFF_CCKVS = OFF_WIN;
constexpr size_t OFF_WQB = 24 * MiB;
constexpr size_t OFF_WKVB = 26 * MiB;
constexpr size_t OFF_WO = 28 * MiB;
constexpr size_t OFF_R1 = 36 * MiB;
constexpr size_t OFF_Z = 100 * MiB;
constexpr size_t OFF_Q = 236 * MiB;
constexpr size_t OFF_KV = 284 * MiB;
constexpr size_t OFF_KVL = 316 * MiB;
constexpr size_t OFF_X1B = OFF_KV;
constexpr size_t OFF_ACT = OFF_Z;
constexpr size_t OFF_WGU = 352 * MiB;
constexpr size_t OFF_WD = 396 * MiB;
constexpr size_t OFF_STAT = 418 * MiB;
constexpr size_t OFF_FLAG = OFF_BAR + 16 * KiB;
constexpr size_t CTL_BYTES = 32 * KiB + 3 * NMOD * 4;
constexpr size_t WS_NEED = 420 * MiB;
static_assert(OFF_KRL + 2 * 4608 * 64 * 2 <= OFF_BAR && OFF_BAR + CTL_BYTES <= OFF_WIN && OFF_KVL == OFF_KV + (size_t)NCTX * 2048 * 2, "ws map");

__device__ __forceinline__ unsigned cvtpk(float lo, float hi) { unsigned r; asm("v_cvt_pk_bf16_f32 %0, %1, %2" : "=v"(r) : "v"(lo), "v"(hi)); return r; }
__device__ __forceinline__ float bflo(unsigned w) { return __uint_as_float(w << 16); }
__device__ __forceinline__ float bfhi(unsigned w) { return __uint_as_float(w & 0xffff0000u); }
__device__ __forceinline__ float bf2f(short h) { return __uint_as_float(((unsigned)(unsigned short)h) << 16); }
__device__ __forceinline__ short f2bf(float f) { return (short)(cvtpk(f, 0.f) & 0xffffu); }
__device__ __forceinline__ float wave_sum(float v) {
#pragma unroll
    for (int o = 1; o < 64; o <<= 1) v += __shfl_xor(v, o);
    return v;
}
__device__ __forceinline__ float silu_f(float x) { return x * __builtin_amdgcn_rcpf(1.f + __expf(-x)); }
#define LDS_WAIT() asm volatile("s_waitcnt lgkmcnt(0)" ::: "memory")
__device__ __forceinline__ void st16_wt(void* p, u32x4 v) { asm volatile("global_store_dwordx4 %0, %1, off sc1\n\ts_nop 2" :: "v"(p), "v"(v) : "memory"); }
__device__ __forceinline__ void st2_wt(void* p, unsigned v) { asm volatile("global_store_short %0, %1, off sc1" :: "v"(p), "v"(v) : "memory"); }
__device__ __forceinline__ void st8_wt(void* p, u32x2 v) { asm volatile("global_store_dwordx2 %0, %1, off sc1" :: "v"(p), "v"(v) : "memory"); }

namespace pg8 {
constexpr int BM = 256, BK = 64, HALF = 128, HTB = HALF * BK * 2, NXCD = 8, WGM = 8;
__host__ __device__ __forceinline__ int lds_byte(int r, int c) { const int st = (r >> 4) * 2 + (c >> 5), rr = r & 15, cc = c & 31, ob = rr * 64 + cc * 2; return st * 1024 + (ob ^ (((ob >> 9) & 1) << 5)); }
__host__ __device__ __forceinline__ void stage_rc(int b, int& R, int& C) { const int st = b / 1024, sb = b % 1024, swz = sb ^ (((sb >> 9) & 1) << 5); R = (st >> 1) * 16 + swz / 64; C = (st & 1) * 32 + (swz % 64) / 2; }
__host__ __device__ __forceinline__ int perm32(int rho) { const int n = rho >> 4, i = rho & 15; return 8 * (i >> 2) + 4 * n + (i & 3); }

struct Unit { int pm, pn, kind; };
struct Gemm { const bf16_t* A; const bf16_t* Bt; int M, N, K, lda; };

struct StaticOrder {
    int nM, nN, nwg, G, c;
    __device__ __forceinline__ void init(int M, int N, int G_, int c_) { nM = M / BM; nN = N / BM; nwg = nM * nN; G = G_; c = c_; }
    __device__ __forceinline__ bool next(int i, Unit& u) const { return map((long)i * G + c, u); }
    __device__ __forceinline__ const char* aptr(const Gemm& g, const Unit& u, size_t tstepA) const { return (const char*)g.A + (size_t)u.pm * tstepA; }
    __device__ __forceinline__ const char* bptr(const Gemm& g, const Unit& u, size_t tstepB) const { return (const char*)g.Bt + (size_t)u.pn * tstepB; }
    __device__ __forceinline__ bool map(long L, Unit& u) const {
        u.kind = 0; if (L >= nwg) return false;
        int wgid = (int)L; { const int q = nwg / NXCD, r = nwg % NXCD, xcd = wgid % NXCD, off = wgid / NXCD; wgid = (xcd < r ? xcd * (q + 1) : r * (q + 1) + (xcd - r) * q) + off; }
        const int nig = WGM * nN, gid = wgid / nig, fm = gid * WGM, gsz = (nM - fm) < WGM ? (nM - fm) : WGM;
        u.pm = fm + ((wgid % nig) % gsz); u.pn = (wgid % nig) / gsz; return true;
    }
};

template <bool ALIGN_EPI, class Epi, class Sched>
__device__ __forceinline__ void gemm_phase(LAS unsigned char* lds, const Gemm g, const Sched& S, const Epi& E) {
    const int tid = threadIdx.x, wid = __builtin_amdgcn_readfirstlane(tid >> 6), lane = tid & 63, wr = wid >> 2, wc = wid & 3, fr = lane & 15, fq = lane >> 4;
    const int K = g.K, nt = K / BK, lda = g.lda;
    unsigned voffA[2], voffB[2];
#pragma unroll
    for (int i = 0; i < 2; ++i) { int R, C; stage_rc(tid * 16 + i * 8192, R, C); const int Rb = (R & ~31) + perm32(R & 31);
        voffA[i] = (unsigned)(R * lda + C) * 2u; voffB[i] = (unsigned)(Rb * K + C) * 2u; }
    const size_t kstep = (size_t)(BK * 2);
    const size_t hstepA = (size_t)HALF * lda * 2, hstepB = (size_t)HALF * K * 2;
    const size_t tstepA = 2 * hstepA, tstepB = 2 * hstepB;
    const unsigned ldsw = (unsigned)wid * 1024u;
    const int aoff = lds_byte(wr * 64 + fr, fq * 8), boff = lds_byte(wc * 32 + fr, fq * 8);
#define PG8_SA(b, h) (((b) * 2 + (h)) * HTB)
#define PG8_SB(b, h) ((4 + (b) * 2 + (h)) * HTB)
#define PG8_STAGE(bufoff, gbase, voff) do { _Pragma("unroll") for (int _i = 0; _i < 2; ++_i) \
        __builtin_amdgcn_global_load_lds((const unsigned*)((const char*)(gbase) + (voff)[_i]), (LAS unsigned*)(lds + (bufoff) + ldsw + _i * 8192), 16, 0, 0); } while (0)
#define PG8_LDA(dst, b, h) do { _Pragma("unroll") for (int m = 0; m < 4; ++m) _Pragma("unroll") for (int k = 0; k < 2; ++k) dst[m][k] = *(const LAS bf16x8*)(lds + PG8_SA(b, h) + aoff + m * 2048 + k * 1024); } while (0)
#define PG8_LDB(dst, b, h) do { _Pragma("unroll") for (int n = 0; n < 2; ++n) _Pragma("unroll") for (int k = 0; k < 2; ++k) dst[n][k] = *(const LAS bf16x8*)(lds + PG8_SB(b, h) + boff + n * 2048 + k * 1024); } while (0)
#define PG8_MMA(ai, bj, At, Bt) do { __builtin_amdgcn_s_setprio(1); _Pragma("unroll") for (int m = 0; m < 4; ++m) _Pragma("unroll") for (int n = 0; n < 2; ++n) _Pragma("unroll") for (int k = 0; k < 2; ++k) \
        acc[ai][bj][m][n] = __builtin_amdgcn_mfma_f32_16x16x32_bf16(Bt[n][k], At[m][k], acc[ai][bj][m][n], 0, 0, 0); __builtin_amdgcn_s_setprio(0); } while (0)
#define PG8_WAIT_V(n) asm volatile("s_waitcnt vmcnt(" #n ")" ::: "memory")
#define PG8_WAIT_L(n) asm volatile("s_waitcnt lgkmcnt(" #n ")" ::: "memory")
#define PG8_BAR __builtin_amdgcn_s_barrier()
#define PG8_SCHED __builtin_amdgcn_sched_barrier(0)
    Unit cur, nxt; int ui = 0;
    if (!S.next(0, cur)) return;
    f32x4 acc[2][2][4][2];
    int est = 0;
    if constexpr (Epi::HAS_INIT) est = E.init(acc, cur, wr, wc);
    else {
#pragma unroll
    for (int a = 0; a < 2; ++a)
#pragma unroll
        for (int b = 0; b < 2; ++b)
#pragma unroll
            for (int m = 0; m < 4; ++m)
#pragma unroll
                for (int n = 0; n < 2; ++n) acc[a][b][m][n] = (f32x4){0.f, 0.f, 0.f, 0.f};
    }
    bf16x8 At[4][2], B0[2][2], B1[2][2];
    const char* cA = S.aptr(g, cur, tstepA); const char* cB = S.bptr(g, cur, tstepB);
    PG8_STAGE(PG8_SB(0, 0), cB, voffB); PG8_STAGE(PG8_SB(0, 1), cB + hstepB, voffB); PG8_STAGE(PG8_SA(0, 0), cA, voffA); PG8_STAGE(PG8_SA(0, 1), cA + hstepA, voffA);
    if (wr == 1) PG8_BAR;
    PG8_WAIT_V(2); PG8_BAR;
    PG8_STAGE(PG8_SB(1, 0), cB + kstep, voffB); PG8_STAGE(PG8_SA(1, 0), cA + kstep, voffA); PG8_STAGE(PG8_SB(1, 1), cB + hstepB + kstep, voffB);
    PG8_WAIT_V(6); PG8_BAR;
    for (;;) {
        const bool has_next = S.next(ui + 1, nxt);
        const char* nA = has_next ? S.aptr(g, nxt, tstepA) : cA; const char* nB = has_next ? S.bptr(g, nxt, tstepB) : cB;
        for (int t = 0; t < nt; t += 2) {
            const bool last = (t == nt - 2);
            const char* a1 = cA + (size_t)(t + 1) * kstep;
            const char* a2 = last ? nA : cA + (size_t)(t + 2) * kstep; const char* b2 = last ? nB : cB + (size_t)(t + 2) * kstep;
            const char* a3 = a2 + kstep; const char* b3 = b2 + kstep;
            PG8_LDB(B0, 0, 0); PG8_LDB(B1, 0, 1); PG8_SCHED; PG8_LDA(At, 0, 0); PG8_STAGE(PG8_SA(1, 1), a1 + hstepA, voffA);
            PG8_WAIT_V(8); PG8_WAIT_L(0); PG8_BAR; PG8_MMA(0, 0, At, B0); PG8_MMA(0, 1, At, B1); PG8_BAR; PG8_SCHED;
            PG8_LDA(At, 0, 1); PG8_STAGE(PG8_SB(0, 0), b2, voffB); PG8_STAGE(PG8_SB(0, 1), b2 + hstepB, voffB); PG8_STAGE(PG8_SA(0, 0), a2, voffA);
            PG8_WAIT_V(8); PG8_WAIT_L(0); PG8_BAR; PG8_MMA(1, 0, At, B0); PG8_MMA(1, 1, At, B1); PG8_BAR; PG8_SCHED;
            PG8_LDB(B0, 1, 0); PG8_LDB(B1, 1, 1); PG8_SCHED; PG8_LDA(At, 1, 0); PG8_STAGE(PG8_SA(0, 1), a2 + hstepA, voffA);
            PG8_WAIT_V(8); PG8_WAIT_L(0); PG8_BAR; PG8_MMA(0, 0, At, B0); PG8_MMA(0, 1, At, B1); PG8_BAR; PG8_SCHED;
            PG8_LDA(At, 1, 1); PG8_STAGE(PG8_SB(1, 0), b3, voffB); PG8_STAGE(PG8_SB(1, 1), b3 + hstepB, voffB); PG8_STAGE(PG8_SA(1, 0), a3, voffA);
            PG8_WAIT_V(8); PG8_WAIT_L(0); PG8_BAR; PG8_MMA(1, 0, At, B0); PG8_MMA(1, 1, At, B1); PG8_BAR; PG8_SCHED;
        }
        if constexpr (ALIGN_EPI) { if (wr == 0) PG8_BAR; }
        if constexpr (Epi::HAS_INIT) E(acc, cur, wr, wc, fr, fq, est); else E(acc, cur, wr, wc, fr, fq);
        if (!has_next) break;
        if constexpr (Epi::HAS_INIT) est = E.init(acc, nxt, wr, wc);
        else {
#pragma unroll
        for (int a = 0; a < 2; ++a)
#pragma unroll
            for (int b = 0; b < 2; ++b)
#pragma unroll
                for (int m = 0; m < 4; ++m)
#pragma unroll
                    for (int n = 0; n < 2; ++n) acc[a][b][m][n] = (f32x4){0.f, 0.f, 0.f, 0.f};
        }
        cur = nxt; cA = nA; cB = nB; ++ui;
        if constexpr (ALIGN_EPI) { if (wr == 1) PG8_BAR; }
    }
    PG8_WAIT_V(0);
    if constexpr (!ALIGN_EPI) { if (wr == 0) PG8_BAR; }
    PG8_BAR;
#undef PG8_SA
#undef PG8_SB
#undef PG8_STAGE
#undef PG8_LDA
#undef PG8_LDB
#undef PG8_MMA
#undef PG8_WAIT_V
#undef PG8_WAIT_L
#undef PG8_BAR
#undef PG8_SCHED
}

__device__ __forceinline__ u32x4 pack8(const f32x4 v0, const f32x4 v1) { u32x4 w; w.x = cvtpk(v0[0], v0[1]); w.y = cvtpk(v0[2], v0[3]); w.z = cvtpk(v1[0], v1[1]); w.w = cvtpk(v1[2], v1[3]); return w; }

struct EpiBf16 {
    static constexpr bool HAS_INIT = false;
    bf16_t* O; int ldc; int mode;
    __device__ __forceinline__ void operator()(const f32x4 (&acc)[2][2][4][2], const Unit& u, int wr, int wc, int fr, int fq) const {
        int rb = u.pm * BM;
        if (mode == 1) { if (u.pm >= 32) { const int b = (u.pm - 32) >> 4; rb += b * 512; } }
        else if (mode == 2) { const int b = u.pm >> 1; rb = NCTX + b * 4608 + 4096 + (u.pm & 1) * BM; }
        const int row0 = rb + wr * 64 + fr, col0 = u.pn * BM + wc * 32 + 8 * fq;
#pragma unroll
        for (int ai = 0; ai < 2; ++ai)
#pragma unroll
            for (int m = 0; m < 4; ++m) { bf16_t* rowp = O + (size_t)(row0 + ai * HALF + m * 16) * ldc + col0;
#pragma unroll
                for (int bj = 0; bj < 2; ++bj) st16_wt(rowp + bj * HALF, pack8(acc[ai][bj][m][0], acc[ai][bj][m][1])); }
    }
};
struct P4Order {
    StaticOrder so; const char* ws; int G, c;
    __device__ __forceinline__ bool next(int i, Unit& u) const {
        const long L = (long)i * G + c;
        if (L < 896) { so.map(L, u); if (u.pn < 8) u.kind = 1; else { u.kind = 0; u.pn -= 8; } return true; }
        if (L < 928) { const int idx = (int)L - 896; u.pm = idx >> 3; u.pn = idx & 7; u.kind = 2; return true; }
        return false;
    }
    __device__ __forceinline__ const char* aptr(const Gemm&, const Unit& u, size_t tstepA) const {
        const size_t off = (u.kind == 1) ? (OFF_Z + (size_t)ZKVL * 2) : ((u.kind == 0) ? (OFF_Z + (size_t)ZQL * 2) : OFF_CCKVS);
        return ws + off + (size_t)u.pm * tstepA; }
    __device__ __forceinline__ const char* bptr(const Gemm&, const Unit& u, size_t tstepB) const {
        const size_t off = (u.kind == 0) ? OFF_WQB : OFF_WKVB;
        return ws + off + (size_t)u.pn * tstepB; }
};
struct EpiP4 {
    static constexpr bool HAS_INIT = false;
    bf16_t* Q; bf16_t* KV;
    __device__ __forceinline__ void operator()(const f32x4 (&acc)[2][2][4][2], const Unit& u, int wr, int wc, int fr, int fq) const {
        if (u.kind == 0) { EpiBf16 e{Q, 1536, 0}; e(acc, u, wr, wc, fr, fq); } else { EpiBf16 e{KV, 2048, u.kind}; e(acc, u, wr, wc, fr, fq); }
    }
};
struct EpiInProj {
    static constexpr bool HAS_INIT = false;
    bf16_t* Z; float* sK; float* sV; float* sKR;
    __device__ __forceinline__ void operator()(const f32x4 (&acc)[2][2][4][2], const Unit& u, int wr, int wc, int fr, int fq) const {
        const int row0 = u.pm * BM + wr * 64 + fr, col0 = u.pn * BM + wc * 32 + 8 * fq;
#pragma unroll
        for (int ai = 0; ai < 2; ++ai)
#pragma unroll
            for (int m = 0; m < 4; ++m) { bf16_t* rowp = Z + (size_t)(row0 + ai * HALF + m * 16) * INCP + col0;
#pragma unroll
                for (int bj = 0; bj < 2; ++bj) st16_wt(rowp + bj * HALF, pack8(acc[ai][bj][m][0], acc[ai][bj][m][1])); }
        if (u.pm < NCTX / BM) {
            if (u.pn >= 4 && u.pn < 12) {
                float* dst = (u.pn < 8 ? sK : sV); const int cb = (u.pn & 3) * BM + wc * 32 + 8 * fq;
#pragma unroll
                for (int ai = 0; ai < 2; ++ai)
#pragma unroll
                    for (int m = 0; m < 4; ++m) { float* rowp = dst + (size_t)(row0 + ai * HALF + m * 16) * 1024 + cb;
#pragma unroll
                        for (int bj = 0; bj < 2; ++bj) { __builtin_nontemporal_store(acc[ai][bj][m][0], (f32x4*)(rowp + bj * HALF)); __builtin_nontemporal_store(acc[ai][bj][m][1], (f32x4*)(rowp + bj * HALF + 4)); } }
            } else if (u.pn == 16 && wc < 2) {
                const int cb = wc * 32 + 8 * fq;
#pragma unroll
                for (int ai = 0; ai < 2; ++ai)
#pragma unroll
                    for (int m = 0; m < 4; ++m) { float* rowp = sKR + (size_t)(row0 + ai * HALF + m * 16) * 64 + cb;
                        __builtin_nontemporal_store(acc[ai][0][m][0], (f32x4*)(rowp)); __builtin_nontemporal_store(acc[ai][0][m][1], (f32x4*)(rowp + 4)); }
            }
        }
    }
};
struct EpiResid {
    static constexpr bool HAS_INIT = false;
    const float* srcA; const float* srcB; float* out; const float* gate;
    __device__ __forceinline__ void operator()(const f32x4 (&acc)[2][2][4][2], const Unit& u, int wr, int wc, int fr, int fq) const {
        const int row0 = u.pm * BM + wr * 64 + fr, col0 = u.pn * BM + wc * 32 + 8 * fq;
        const int v = (u.pm < 32) ? 0 : 1 + ((u.pm - 32) >> 4);
        const float* src = (u.pm < 32) ? srcA : srcB - (size_t)NCTX * DM;
        f32x4 gv[2][2];
#pragma unroll
        for (int bj = 0; bj < 2; ++bj)
#pragma unroll
            for (int n = 0; n < 2; ++n) gv[bj][n] = *(const f32x4*)(gate + (size_t)v * NMOD + col0 + bj * HALF + 4 * n);
#pragma unroll
        for (int ai = 0; ai < 2; ++ai)
#pragma unroll
            for (int m = 0; m < 4; ++m) { const size_t ro = (size_t)(row0 + ai * HALF + m * 16) * DM + col0;
#pragma unroll
                for (int bj = 0; bj < 2; ++bj)
#pragma unroll
                    for (int n = 0; n < 2; ++n) { const f32x4 xs = *(const f32x4*)(src + ro + bj * HALF + 4 * n);
                        *(f32x4*)(out + ro + bj * HALF + 4 * n) = xs * ALPHA + gv[bj][n] * acc[ai][bj][m][n]; } }
    }
};
struct EpiSwiGLU {
    static constexpr bool HAS_INIT = false;
    bf16_t* O;
    __device__ __forceinline__ void operator()(const f32x4 (&acc)[2][2][4][2], const Unit& u, int wr, int wc, int fr, int fq) const {
        const int row0 = u.pm * BM + wr * 64 + fr, col0 = u.pn * HALF + wc * 32 + 8 * fq;
#pragma unroll
        for (int ai = 0; ai < 2; ++ai)
#pragma unroll
            for (int m = 0; m < 4; ++m) { f32x4 f0, f1;
#pragma unroll
                for (int j = 0; j < 4; ++j) { f0[j] = silu_f(acc[ai][0][m][0][j]) * acc[ai][1][m][0][j]; f1[j] = silu_f(acc[ai][0][m][1][j]) * acc[ai][1][m][1][j]; }
                st16_wt(O + (size_t)(row0 + ai * HALF + m * 16) * DFF + col0, pack8(f0, f1)); }
    }
};

struct PanelOrder {
    int c;
    __device__ __forceinline__ bool next(int i, Unit& u) const { u.kind = 0; if (i >= 2) return false; const int xcd = c & 7, off = c >> 3; u.pm = xcd * 8 + i * 4 + (off >> 3); u.pn = off & 7; return true; }
    __device__ __forceinline__ const char* aptr(const Gemm& g, const Unit& u, size_t tstepA) const { return (const char*)g.A + (size_t)u.pm * tstepA; }
    __device__ __forceinline__ const char* bptr(const Gemm& g, const Unit& u, size_t tstepB) const { return (const char*)g.Bt + (size_t)u.pn * tstepB; }
};
template <bool H2, bool SRC_BF, bool OUT_BF> struct EpiResidLN {
    const float* srcA; const float* srcB; const bf16_t* srcH; float* out; bf16_t* outH; const float* gate; const float* lng; const float* lnb; const float* modsh2; bf16_t* Hb;
    float* stats; unsigned* flags; LAS unsigned char* xl;
    __device__ __forceinline__ void ldsrc(const float* src, size_t ro, f32x4& x0, f32x4& x1) const {
        if constexpr (SRC_BF) { const u32x4 w = *(const u32x4*)(srcH + ro); x0 = (f32x4){bflo(w.x), bfhi(w.x), bflo(w.y), bfhi(w.y)}; x1 = (f32x4){bflo(w.z), bfhi(w.z), bflo(w.w), bfhi(w.w)}; }
        else { x0 = *(const f32x4*)(src + ro); x1 = *(const f32x4*)(src + ro + 4); }
    }
    __device__ __forceinline__ void ldsrc_nt(const float* src, size_t ro, f32x4& x0, f32x4& x1) const {
        if constexpr (SRC_BF) { const u32x4 w = __builtin_nontemporal_load((const u32x4*)(srcH + ro)); x0 = (f32x4){bflo(w.x), bfhi(w.x), bflo(w.y), bfhi(w.y)}; x1 = (f32x4){bflo(w.z), bfhi(w.z), bflo(w.w), bfhi(w.w)}; }
        else { x0 = __builtin_nontemporal_load((const f32x4*)(src + ro)); x1 = __builtin_nontemporal_load((const f32x4*)(src + ro + 4)); }
    }
    static constexpr bool HAS_INIT = true;
    __device__ __forceinline__ int init(f32x4 (&acc)[2][2][4][2], const Unit& u, int wr, int wc) const {
        int tid = threadIdx.x; asm volatile("" : "+v"(tid));
        const int lane = tid & 63, fr = tid & 15, fq = (tid >> 4) & 3;
        const int v = (u.pm < 32) ? 0 : 1 + ((u.pm - 32) >> 4);
        const float* gcol = gate + (size_t)v * NMOD + u.pn * BM;
        const f32x4 gc = *(const f32x4*)(gcol + lane * 4);
        const float mn = fminf(fminf(fabsf(gc.x), fabsf(gc.y)), fminf(fabsf(gc.z), fabsf(gc.w)));
        const int slow = __any(!(mn >= 1e-18f)) ? 1 : 0;
        if (slow) {
#pragma unroll
            for (int a = 0; a < 2; ++a)
#pragma unroll
                for (int b = 0; b < 2; ++b)
#pragma unroll
                    for (int m = 0; m < 4; ++m)
#pragma unroll
                        for (int n = 0; n < 2; ++n) acc[a][b][m][n] = (f32x4){0.f, 0.f, 0.f, 0.f};
            return 1;
        }
        const int row0 = u.pm * BM + wr * 64 + fr, col0 = u.pn * BM + wc * 32 + 8 * fq;
        const float* src = (u.pm < 32) ? srcA : srcB - (size_t)NCTX * DM;
        f32x4 gi[2][2];
#pragma unroll
        for (int bj = 0; bj < 2; ++bj)
#pragma unroll
            for (int n = 0; n < 2; ++n) { const f32x4 gvv = *(const f32x4*)(gcol + wc * 32 + 8 * fq + bj * HALF + 4 * n);
                gi[bj][n] = (f32x4){ALPHA / gvv.x, ALPHA / gvv.y, ALPHA / gvv.z, ALPHA / gvv.w}; }
#pragma unroll
        for (int ai = 0; ai < 2; ++ai)
#pragma unroll
            for (int m = 0; m < 4; ++m) { const size_t ro = (size_t)(row0 + ai * HALF + m * 16) * DM + col0;
#pragma unroll
                for (int bj = 0; bj < 2; ++bj) { f32x4 x0, x1; ldsrc_nt(src, ro + bj * HALF, x0, x1);
                    acc[ai][bj][m][0] = x0 * gi[bj][0]; acc[ai][bj][m][1] = x1 * gi[bj][1]; } }
        return 0;
    }
    __device__ __forceinline__ void operator()(const f32x4 (&acc)[2][2][4][2], const Unit& u, int wr, int wc, int fr_, int fq_, int slow) const {
        int tid = threadIdx.x; asm volatile("" : "+v"(tid));
        const int fr = tid & 15, fq = (tid >> 4) & 3;
        const int row0 = u.pm * BM + wr * 64 + fr, col0 = u.pn * BM + wc * 32 + 8 * fq;
        const int v = (u.pm < 32) ? 0 : 1 + ((u.pm - 32) >> 4);
        const float* src = (u.pm < 32) ? srcA : srcB - (size_t)NCTX * DM;
        LAS float* part = (LAS float*)xl;
        LAS float* rowst = (LAS float*)(xl + 8192);
        {
            f32x4 gv[2][2];
#pragma unroll
            for (int bj = 0; bj < 2; ++bj)
#pragma unroll
                for (int n = 0; n < 2; ++n) gv[bj][n] = *(const f32x4*)(gate + (size_t)v * NMOD + col0 + bj * HALF + 4 * n);
#pragma unroll
            for (int ai = 0; ai < 2; ++ai)
#pragma unroll
                for (int m = 0; m < 4; ++m) { const size_t ro = (size_t)(row0 + ai * HALF + m * 16) * DM + col0; float a = 0.f, b = 0.f;
#pragma unroll
                    for (int bj = 0; bj < 2; ++bj) { f32x4 t0 = gv[bj][0] * acc[ai][bj][m][0], t1 = gv[bj][1] * acc[ai][bj][m][1];
                        if (slow) { f32x4 x0, x1; ldsrc(src, ro + bj * HALF, x0, x1); t0 += x0 * ALPHA; t1 += x1 * ALPHA; }
                        a += ((t0.x + t0.y) + (t0.z + t0.w)) + ((t1.x + t1.y) + (t1.z + t1.w));
                        b += ((t0.x * t0.x + t0.y * t0.y) + (t0.z * t0.z + t0.w * t0.w)) + ((t1.x * t1.x + t1.y * t1.y) + (t1.z * t1.z + t1.w * t1.w)); }
                    if (slow && (m == 1 || m == 3)) { asm volatile("" ::: "memory"); __builtin_amdgcn_sched_barrier(0); }
                    a += __shfl_xor(a, 16); b += __shfl_xor(b, 16); a += __shfl_xor(a, 32); b += __shfl_xor(b, 32);
                    if (fq == 0) { const int rl = ai * HALF + wr * 64 + m * 16 + fr; part[(wc * 256 + rl) * 2] = a; part[(wc * 256 + rl) * 2 + 1] = b; } }
        }
        __syncthreads();
        unsigned long long* st = (unsigned long long*)stats + (size_t)(u.pm * 8 + u.pn) * 256;
        if (tid < 256) { float S1 = 0.f, S2 = 0.f;
#pragma unroll
            for (int w = 0; w < 4; ++w) { S1 += part[(w * 256 + tid) * 2]; S2 += part[(w * 256 + tid) * 2 + 1]; }
            const unsigned long long pk = (unsigned long long)__float_as_uint(S1) | ((unsigned long long)__float_as_uint(S2) << 32);
            __hip_atomic_store(st + tid, pk, __ATOMIC_RELAXED, __HIP_MEMORY_SCOPE_AGENT); }
        asm volatile("s_waitcnt vmcnt(0)" ::: "memory");
        __syncthreads();
        if (tid == 0) {
            __hip_atomic_fetch_add(flags + u.pm, 1u, __ATOMIC_RELAXED, __HIP_MEMORY_SCOPE_AGENT);
            unsigned sp = 0;
            while (__hip_atomic_load(flags + u.pm, __ATOMIC_RELAXED, __HIP_MEMORY_SCOPE_AGENT) < 8u) { __builtin_amdgcn_s_sleep(1); if (++sp > (1u << 22)) break; }
        }
        __syncthreads();
        if (tid < 256) { float S1 = 0.f, S2 = 0.f; const unsigned long long* sp0 = (const unsigned long long*)stats + (size_t)(u.pm * 8) * 256 + tid;
#pragma unroll
            for (int t = 0; t < 8; ++t) { const unsigned long long pk = __hip_atomic_load(sp0 + t * 256, __ATOMIC_RELAXED, __HIP_MEMORY_SCOPE_AGENT);
                S1 += __uint_as_float((unsigned)pk); S2 += __uint_as_float((unsigned)(pk >> 32)); }
            const float mean = S1 * (1.f / DM), var = fmaxf(S2 * (1.f / DM) - mean * mean, 0.f);
            rowst[tid * 2] = mean; rowst[tid * 2 + 1] = rsqrtf(var + LN_EPS); }
        __syncthreads();
        const float* sh2 = modsh2 + (size_t)v * NMOD; const float* sc2 = sh2 + DM;
        int col0b = col0; asm volatile("" : "+v"(col0b));
#pragma unroll
        for (int bj = 0; bj < 2; ++bj) { const int c = col0b + bj * HALF;
            const f32x4 g0 = *(const f32x4*)(lng + c), g1 = *(const f32x4*)(lng + c + 4), b0 = *(const f32x4*)(lnb + c), b1 = *(const f32x4*)(lnb + c + 4);
            const f32x4 gt0 = *(const f32x4*)(gate + (size_t)v * NMOD + c), gt1 = *(const f32x4*)(gate + (size_t)v * NMOD + c + 4);
            f32x4 s0, s1, h0, h1;
            if constexpr (H2) { s0 = *(const f32x4*)(sc2 + c) + 1.f; s1 = *(const f32x4*)(sc2 + c + 4) + 1.f; h0 = *(const f32x4*)(sh2 + c); h1 = *(const f32x4*)(sh2 + c + 4); }
#pragma unroll
            for (int ai = 0; ai < 2; ++ai) {
#pragma unroll
                for (int m = 0; m < 4; ++m) { const int rl = ai * HALF + wr * 64 + m * 16 + fr; const float mean = rowst[rl * 2], rstd = rowst[rl * 2 + 1];
                    const size_t ro = (size_t)(u.pm * BM + rl) * DM + c;
                    f32x4 t0 = gt0 * acc[ai][bj][m][0], t1 = gt1 * acc[ai][bj][m][1];
                    if (slow) { f32x4 x0, x1; ldsrc_nt(src, ro, x0, x1); t0 += x0 * ALPHA; t1 += x1 * ALPHA; }
                    const f32x4 y0 = (t0 - mean) * rstd * g0 + b0, y1 = (t1 - mean) * rstd * g1 + b1;
                    if constexpr (OUT_BF) st16_wt(outH + ro, pack8(y0, y1));
                    else { __builtin_nontemporal_store(y0, (f32x4*)(out + ro)); __builtin_nontemporal_store(y1, (f32x4*)(out + ro + 4)); }
                    if constexpr (H2) st16_wt(Hb + ro, pack8(y0 * s0 + h0, y1 * s1 + h1)); }
                if (slow) { asm volatile("" ::: "memory"); __builtin_amdgcn_sched_barrier(0); } } }
        __syncthreads();
    }
};
}

namespace att {
constexpr int QBLK = 32, KVBLK = 64;
constexpr int SHM_V = KVBLK * 128 * 2, SHM_K = KVBLK * 128 * 2, SHM_KR = KVBLK * 64 * 2;
constexpr int L_V = 0, L_K = 2 * SHM_V, L_KR = L_K + 2 * SHM_K, L_WS = L_KR + 2 * SHM_KR, L_RPB = L_WS + NWAVES * 64 * 4, L_QR = L_RPB + 2048, L_END = L_QR + NWAVES * 4096;
static_assert(L_END <= 131072, "attention LDS");
constexpr float THR = 8.f;
constexpr float NEG = -3.0e38f;
#ifndef ATT_SDEPTH
#define ATT_SDEPTH 1
#endif
constexpr int SDEPTH = ATT_SDEPTH;
#define KSWZ(row, colB) ((row) * 256 + ((colB) ^ (((row) & 7) << 4)))
#define KRSWZ(row, colB) ((row) * 128 + ((colB) ^ (((row) & 7) << 4)))
#define SBAR() __builtin_amdgcn_sched_barrier(0)
__device__ __forceinline__ int crow(int r, int hi) { return (r & 3) + 8 * (r >> 2) + 4 * hi; }
template <int DK> struct Cst { static constexpr float SCALE = (DK == 128) ? 0.08838834764831845f : 0.07216878364870323f; };

template <int DK>
__device__ __forceinline__ void partialSM(f32x16& p0, f32x16& p1, float& m_reg, float& mn, float& alpha) {
    constexpr float SCALE = Cst<DK>::SCALE, C = SCALE * 1.4426950408889634f;
    float pmax = p0[0];
#pragma unroll
    for (int r = 1; r < 16; ++r) pmax = fmaxf(pmax, p0[r]);
#pragma unroll
    for (int r = 0; r < 16; ++r) pmax = fmaxf(pmax, p1[r]);
    { auto rr = __builtin_amdgcn_permlane32_swap(__float_as_uint(pmax), __float_as_uint(pmax), false, false);
      pmax = fmaxf(__uint_as_float(rr[0]), __uint_as_float(rr[1])); }
    if (__builtin_expect(__all(pmax - m_reg <= THR / SCALE), 1)) { mn = m_reg; alpha = 1.f; }
    else { mn = fmaxf(m_reg, pmax); alpha = __builtin_amdgcn_exp2f((m_reg - mn) * C); m_reg = mn; }
    const float mnC = -mn * C;
#pragma unroll
    for (int r = 0; r < 16; ++r) p0[r] = fmaf(p0[r], C, mnC);
#pragma unroll
    for (int r = 0; r < 16; ++r) p1[r] = fmaf(p1[r], C, mnC);
#pragma unroll
    for (int r = 0; r < 16; ++r) p0[r] = __builtin_amdgcn_exp2f(p0[r]);
}
__device__ __forceinline__ void finishSM(f32x16& p0, f32x16& p1, float alpha, float& l_reg, bf16x8& pa0, bf16x8& pa1, bf16x8& pa2, bf16x8& pa3) {
#pragma unroll
    for (int r = 0; r < 16; ++r) p1[r] = __builtin_amdgcn_exp2f(p1[r]);
    float ps = 0;
#pragma unroll
    for (int r = 0; r < 16; ++r) ps += p0[r];
#pragma unroll
    for (int r = 0; r < 16; ++r) ps += p1[r];
    { auto rr = __builtin_amdgcn_permlane32_swap(__float_as_uint(ps), __float_as_uint(ps), false, false);
      ps = __uint_as_float(rr[0]) + __uint_as_float(rr[1]); }
    l_reg = l_reg * alpha + ps;
#define PK4(P, BASE, OUT) do { unsigned a0 = cvtpk(P[BASE + 0], P[BASE + 1]), a1 = cvtpk(P[BASE + 2], P[BASE + 3]);   \
    unsigned b0 = cvtpk(P[BASE + 4], P[BASE + 5]), b1 = cvtpk(P[BASE + 6], P[BASE + 7]);                              \
    auto r0 = __builtin_amdgcn_permlane32_swap(a0, b0, false, false); auto r1 = __builtin_amdgcn_permlane32_swap(a1, b1, false, false); \
    u32x4 w = {r0[0], r1[0], r0[1], r1[1]}; OUT = *reinterpret_cast<bf16x8*>(&w); } while (0)
    PK4(p0, 0, pa0); PK4(p0, 8, pa1); PK4(p1, 0, pa2); PK4(p1, 8, pa3);
#undef PK4
}
template <int DK>
__device__ __forceinline__ void qkt(f32x16& p0, f32x16& p1, const char* Ks, const char* Krs, const bf16x8* qr, const char* Qrl, int r32, int hi) {
    p0 = f32x16{}; p1 = f32x16{};
#pragma unroll
    for (int d0 = 0; d0 < 8; ++d0) { const int cb = (d0 * 16 + hi * 8) * 2;
        bf16x8 b0 = *reinterpret_cast<const bf16x8*>(Ks + KSWZ(r32, cb));
        bf16x8 b1 = *reinterpret_cast<const bf16x8*>(Ks + KSWZ(32 + r32, cb));
        p0 = __builtin_amdgcn_mfma_f32_32x32x16_bf16(b0, qr[d0], p0, 0, 0, 0);
        p1 = __builtin_amdgcn_mfma_f32_32x32x16_bf16(b1, qr[d0], p1, 0, 0, 0); }
    if constexpr (DK == 192) {
#pragma unroll
        for (int d0 = 0; d0 < 4; ++d0) { const int cb = (d0 * 16 + hi * 8) * 2;
            bf16x8 b0 = *reinterpret_cast<const bf16x8*>(Krs + KRSWZ(r32, cb));
            bf16x8 b1 = *reinterpret_cast<const bf16x8*>(Krs + KRSWZ(32 + r32, cb));
            const bf16x8 qd = *reinterpret_cast<const bf16x8*>(Qrl + d0 * 1024);
            p0 = __builtin_amdgcn_mfma_f32_32x32x16_bf16(b0, qd, p0, 0, 0, 0);
            p1 = __builtin_amdgcn_mfma_f32_32x32x16_bf16(b1, qd, p1, 0, 0, 0); }
    }
}
__device__ __forceinline__ int v_st(int k, int c) { const int kk = (k & ~0xC) | ((k & 4) << 1) | ((k & 8) >> 1); return ((kk >> 3) * 4 + (c >> 5)) * 512 + ((kk & 7) * 32 + (c & 31)) * 2; }
__device__ __forceinline__ int v_rd_base(int lane) { return ((lane & 3) << 3) | (((lane >> 2) & 3) << 6) | (((lane >> 4) & 1) << 5) | (((lane >> 5) & 1) << 8); }
constexpr int v_rd_off(int d0, int ks, int half) { return d0 * 512 + ks * 4096 + half * 2048; }
template <int OFF> __device__ __forceinline__ s16x4 tr_read(int vb) {
    s16x4 r; asm volatile("ds_read_b64_tr_b16 %0, %1 offset:%2" : "=&v"(r) : "v"(vb), "i"(OFF) : "memory"); return r;
}
template <int D0> __device__ __forceinline__ void pv_one(f32x16& od, int vb, bf16x8 pa0, bf16x8 pa1, bf16x8 pa2, bf16x8 pa3) {
    const s16x4 l0 = tr_read<v_rd_off(D0, 0, 0)>(vb), h0 = tr_read<v_rd_off(D0, 0, 1)>(vb), l1 = tr_read<v_rd_off(D0, 1, 0)>(vb), h1 = tr_read<v_rd_off(D0, 1, 1)>(vb);
    const s16x4 l2 = tr_read<v_rd_off(D0, 2, 0)>(vb), h2 = tr_read<v_rd_off(D0, 2, 1)>(vb), l3 = tr_read<v_rd_off(D0, 3, 0)>(vb), h3 = tr_read<v_rd_off(D0, 3, 1)>(vb);
    asm volatile("s_waitcnt lgkmcnt(0)" ::: "memory"); SBAR();
#define PK(L, H) (bf16x8){L[0], L[1], L[2], L[3], H[0], H[1], H[2], H[3]}
    od = __builtin_amdgcn_mfma_f32_32x32x16_bf16(pa0, PK(l0, h0), od, 0, 0, 0);
    od = __builtin_amdgcn_mfma_f32_32x32x16_bf16(pa1, PK(l1, h1), od, 0, 0, 0);
    od = __builtin_amdgcn_mfma_f32_32x32x16_bf16(pa2, PK(l2, h2), od, 0, 0, 0);
    od = __builtin_amdgcn_mfma_f32_32x32x16_bf16(pa3, PK(l3, h3), od, 0, 0, 0);
#undef PK
}
__device__ __forceinline__ void pv_d0(f32x16* o, int vb, bf16x8 pa0, bf16x8 pa1, bf16x8 pa2, bf16x8 pa3) {
    pv_one<0>(o[0], vb, pa0, pa1, pa2, pa3); pv_one<1>(o[1], vb, pa0, pa1, pa2, pa3); pv_one<2>(o[2], vb, pa0, pa1, pa2, pa3); pv_one<3>(o[3], vb, pa0, pa1, pa2, pa3);
}
__device__ __forceinline__ void na_mask(f32x16& p0, f32x16& p1, bool rowok, const float* tab, int cs, int hi) {
    if (!rowok) {
#pragma unroll
        for (int r = 0; r < 16; ++r) { p0[r] = NEG; p1[r] = NEG; }
    } else {
#pragma unroll
        for (int r = 0; r < 16; ++r) { const int kc = crow(r, hi);
            const bool ok0 = (unsigned)(kc - cs) < 16u, ok1 = (unsigned)(kc + 32 - cs) < 16u;
            const float b0 = tab[ok0 ? kc : cs], b1 = tab[ok1 ? kc + 32 : cs];
            p0[r] = ok0 ? p0[r] + b0 : NEG; p1[r] = ok1 ? p1[r] + b1 : NEG; }
    }
}

struct Seg { const bf16_t* K; const bf16_t* V; const bf16_t* KR; int ldk, ldkr; };

template <int DK, bool LAT, bool SIMPLE>
__device__ __forceinline__ void attn_unit(const bf16_t* __restrict__ Qb, int ldq, const Seg s0, int NT0, const Seg s1, int NT, bf16_t* __restrict__ Ob, char* lds,
                                          int qpos0, int kr0, const float* __restrict__ rpb_h) {
    constexpr int NLD = (DK == 192) ? 5 : 4;
    int tid = threadIdx.x; asm volatile("" : "+v"(tid));
    const int wid = __builtin_amdgcn_readfirstlane(tid >> 6), lane = tid & 63, r32 = lane & 31, hi = lane >> 5;
    char* V_lds = lds + L_V; char* K_lds = lds + L_K; char* KR_lds = lds + L_KR;
    float* ws = (float*)(lds + L_WS) + wid * 64; float* li_l = ws; float* al_l = ws + 32;
    float* rpbL = (float*)(lds + L_RPB);
    __syncthreads();
    if (wid >= 4) __builtin_amdgcn_s_setprio(1);
    if constexpr (LAT && DK == 128) { if (tid < 465) rpbL[tid] = rpb_h[tid] * (1.f / Cst<128>::SCALE); }
    float m_reg = -1e30f, l_reg = 0; f32x16 o[4] = {}; bf16x8 qr[8];
    char* Qrl = lds + L_QR + wid * 4096 + lane * 16;
    const bf16_t* Qw = Qb + (size_t)(wid * QBLK + r32) * ldq + hi * 8;
#pragma unroll
    for (int d0 = 0; d0 < 8; ++d0) qr[d0] = *reinterpret_cast<const bf16x8*>(Qw + d0 * 16);
    if constexpr (DK == 192) {
        bf16x8 q8 = *reinterpret_cast<const bf16x8*>(Qw + 128), q9 = *reinterpret_cast<const bf16x8*>(Qw + 144), q10 = *reinterpret_cast<const bf16x8*>(Qw + 160), q11 = *reinterpret_cast<const bf16x8*>(Qw + 176);
        if constexpr (LAT) {
        const int n = qpos0 + wid * QBLK + r32; const float grow = (float)(n >> 6), gcol = (float)(n & 63);
#pragma unroll
        for (int e = 0; e < 8; ++e) { const float invf = exp2f(-(float)(hi * 8 + e) * (13.287712379549449f / 16.f));
            { const float a = grow * invf, c = __cosf(a), s = __sinf(a), x1 = bf2f(q8[e]), x2 = bf2f(q9[e]); q8[e] = f2bf(x1 * c - x2 * s); q9[e] = f2bf(x2 * c + x1 * s); }
            { const float a = gcol * invf, c = __cosf(a), s = __sinf(a), x1 = bf2f(q10[e]), x2 = bf2f(q11[e]); q10[e] = f2bf(x1 * c - x2 * s); q11[e] = f2bf(x2 * c + x1 * s); } }
        }
        *(bf16x8*)(Qrl) = q8; *(bf16x8*)(Qrl + 1024) = q9; *(bf16x8*)(Qrl + 2048) = q10; *(bf16x8*)(Qrl + 3072) = q11;
    }
    const int qrow = (qpos0 >> 6) + (wid >> 1), qcol = (wid & 1) * 32 + r32;
    const int rs = min(max(qrow - 4, 0), 56), cs = min(max(qcol - 8, 0), 48);
    const int sr = tid >> 4, sc = (tid & 15) * 8, vst0 = v_st(sr, sc), vst1 = v_st(32 + sr, sc);
    const int krr = tid >> 3, krc = (tid & 7) * 8;
    const int vb0 = (int)(uintptr_t)V_lds + v_rd_base(lane);
    struct { bf16x8 vs0, vs1, ks0, ks1, kr; } sr_[SDEPTH];
#define TLOAD(i, j) do { const int _j = (j); const bool _a = !(LAT && DK == 128) || _j < NT0; const int _jj = _a ? _j : _j - NT0; const int _ld = _a ? s0.ldk : s1.ldk; \
    const bf16_t* _K = (_a ? s0.K : s1.K) + (size_t)_jj * KVBLK * _ld; const bf16_t* _V = (_a ? s0.V : s1.V) + (size_t)_jj * KVBLK * _ld; \
    sr_[i].vs0 = *reinterpret_cast<const bf16x8*>(_V + (size_t)sr * _ld + sc); sr_[i].vs1 = *reinterpret_cast<const bf16x8*>(_V + (size_t)(32 + sr) * _ld + sc); \
    sr_[i].ks0 = *reinterpret_cast<const bf16x8*>(_K + (size_t)sr * _ld + sc); sr_[i].ks1 = *reinterpret_cast<const bf16x8*>(_K + (size_t)(32 + sr) * _ld + sc); \
    if constexpr (DK == 192) { const int _lr = _a ? s0.ldkr : s1.ldkr; const bf16_t* _R = (_a ? s0.KR : s1.KR) + (size_t)_jj * KVBLK * _lr; \
        sr_[i].kr = *reinterpret_cast<const bf16x8*>(_R + (size_t)krr * _lr + krc); } } while (0)
#define TWRITE(b, i) do { *(bf16x8*)(V_lds + (b) * SHM_V + vst0) = sr_[i].vs0; *(bf16x8*)(V_lds + (b) * SHM_V + vst1) = sr_[i].vs1; const int kc = sc * 2; \
    *(bf16x8*)(K_lds + (b) * SHM_K + KSWZ(sr, kc)) = sr_[i].ks0; *(bf16x8*)(K_lds + (b) * SHM_K + KSWZ(32 + sr, kc)) = sr_[i].ks1; \
    if constexpr (DK == 192) { *(bf16x8*)(KR_lds + (b) * SHM_KR + KRSWZ(krr, krc * 2)) = sr_[i].kr; } } while (0)
#define SWAIT() do { if constexpr (SDEPTH == 2) { if constexpr (NLD == 5) asm volatile("s_waitcnt vmcnt(5)" ::: "memory"); else asm volatile("s_waitcnt vmcnt(4)" ::: "memory"); } \
    else asm volatile("s_waitcnt vmcnt(0)" ::: "memory"); } while (0)
#define RESC(a) do { if (__any((a) < 1.f)) { if (hi == 0) al_l[r32] = (a); asm volatile("s_waitcnt lgkmcnt(0)" ::: "memory"); \
    _Pragma("unroll") for (int d = 0; d < 4; ++d) _Pragma("unroll") for (int r = 0; r < 16; ++r) o[d][r] *= al_l[crow(r, hi)]; } } while (0)
#define MASK(P0, P1, j) do { if constexpr (LAT && DK == 128) { const int _j = (j); if (_j < NT0) { const int krow = kr0 + _j; \
    const bool rowok = (krow >= rs) && (krow < rs + 8); const int dr = min(max(krow - qrow + 7, 0), 14); na_mask(P0, P1, rowok, rpbL + dr * 31 + 15 - qcol, cs, hi); } } } while (0)
    f32x16 pA0, pA1, pB0, pB1; float mnA, mnB, alA, alB; bf16x8 pa0, pa1, pa2, pa3;
    if constexpr (SIMPLE) {
        TLOAD(0, 0); asm volatile("s_waitcnt vmcnt(0)" ::: "memory"); TWRITE(0, 0); __syncthreads();
        for (int j = 0; j < NT; ++j) {
            const int bb = j & 1;
            if (j + 1 < NT) TLOAD(0, j + 1);
            bool active = true;
            if constexpr (LAT && DK == 128) { if (j < NT0) { const int krow = kr0 + j; active = (krow >= rs) && (krow < rs + 8); } }
            if (active) {
            SBAR(); qkt<DK>(pA0, pA1, K_lds + bb * SHM_K, KR_lds + bb * SHM_KR, qr, Qrl, r32, hi); MASK(pA0, pA1, j); partialSM<DK>(pA0, pA1, m_reg, mnA, alA);
            RESC(alA); finishSM(pA0, pA1, alA, l_reg, pa0, pa1, pa2, pa3); SBAR();
            pv_d0(o, vb0 + bb * SHM_V, pa0, pa1, pa2, pa3);
            }
            if (j + 1 < NT) { if (bb) TWRITE(0, 0); else TWRITE(1, 0); }
            __syncthreads();
        }
    } else {
    constexpr int SE = 0, SO = SDEPTH - 1;
    TLOAD(SE, 0); asm volatile("s_waitcnt vmcnt(0)" ::: "memory"); TWRITE(0, SE); __syncthreads();
    qkt<DK>(pA0, pA1, K_lds, KR_lds, qr, Qrl, r32, hi); MASK(pA0, pA1, 0); partialSM<DK>(pA0, pA1, m_reg, mnA, alA);
    TLOAD(SO, 1); if constexpr (SDEPTH == 2) { if (2 < NT) TLOAD(SE, 2); }
    SWAIT(); TWRITE(1, SO); __syncthreads();
    for (int j = 1; j + 1 < NT; j += 2) {
        SBAR(); qkt<DK>(pB0, pB1, K_lds + SHM_K, KR_lds + SHM_KR, qr, Qrl, r32, hi);
        finishSM(pA0, pA1, alA, l_reg, pa0, pa1, pa2, pa3); SBAR();
        TLOAD(SO, j + SDEPTH); SBAR();
        pv_d0(o, vb0, pa0, pa1, pa2, pa3); MASK(pB0, pB1, j); partialSM<DK>(pB0, pB1, m_reg, mnB, alB);
        __syncthreads(); SWAIT(); TWRITE(0, SE);
        RESC(alB); __syncthreads();
        SBAR(); qkt<DK>(pA0, pA1, K_lds, KR_lds, qr, Qrl, r32, hi);
        finishSM(pB0, pB1, alB, l_reg, pa0, pa1, pa2, pa3); SBAR();
        if (SDEPTH == 1 || j + 3 < NT) TLOAD(SE, j + 1 + SDEPTH); SBAR();
        pv_d0(o, vb0 + SHM_V, pa0, pa1, pa2, pa3); MASK(pA0, pA1, j + 1); partialSM<DK>(pA0, pA1, m_reg, mnA, alA);
        __syncthreads(); SWAIT(); TWRITE(1, SO);
        RESC(alA); __syncthreads();
    }
    SBAR(); qkt<DK>(pB0, pB1, K_lds + SHM_K, KR_lds + SHM_KR, qr, Qrl, r32, hi);
    finishSM(pA0, pA1, alA, l_reg, pa0, pa1, pa2, pa3); SBAR();
    pv_d0(o, vb0, pa0, pa1, pa2, pa3); MASK(pB0, pB1, NT - 1); partialSM<DK>(pB0, pB1, m_reg, mnB, alB);
    __syncthreads(); RESC(alB);
    finishSM(pB0, pB1, alB, l_reg, pa0, pa1, pa2, pa3); SBAR();
    pv_d0(o, vb0 + SHM_V, pa0, pa1, pa2, pa3);
    }
    if (hi == 0) li_l[r32] = l_reg; asm volatile("s_waitcnt lgkmcnt(0)" ::: "memory");
    float rli[16];
#pragma unroll
    for (int r = 0; r < 16; ++r) rli[r] = __builtin_amdgcn_rcpf(li_l[crow(r, hi)]);
    bf16_t* Ow = Ob + (size_t)(wid * QBLK) * DM;
#pragma unroll
    for (int r = 0; r < 16; ++r) { const int orow = crow(r, hi);
#pragma unroll
        for (int d0 = 0; d0 < 4; ++d0) st2_wt(Ow + (size_t)orow * DM + d0 * 32 + r32, (unsigned)(unsigned short)f2bf(o[d0][r] * rli[r])); }
    __builtin_amdgcn_s_setprio(0);
#undef TLOAD
#undef TWRITE
#undef SWAIT
#undef RESC
#undef MASK
}
}

struct Params { const float* in[23]; float* out; unsigned char* ws; int ph_lo, ph_hi, never, pad; };
enum { I_XP = 0, I_XS, I_CNK, I_CNV, I_CCKV, I_CKR, I_C, I_CCTX, I_WMOD, I_BMOD, I_WIN, I_QAN, I_KVAN, I_WQB, I_WKVB, I_RPB, I_WO, I_LN1G, I_LN1B, I_WGU, I_WDOWN, I_LN2G, I_LN2B };

__device__ __forceinline__ void transpose_item(const float* __restrict__ W, int K, int N, bf16_t* __restrict__ WT, int k0, int n0, int rowbase, LAS float* scr, int lane) {
    float tv[32];
#pragma unroll
    for (int i = 0; i < 32; ++i) tv[i] = __builtin_nontemporal_load(W + (size_t)(k0 + 2 * i + (lane >> 5)) * N + n0 + (lane & 31));
#pragma unroll
    for (int i = 0; i < 32; ++i) scr[(2 * i + (lane >> 5)) * 33 + (lane & 31)] = tv[i];
    LDS_WAIT(); asm volatile("" ::: "memory");
    const int c = lane & 7;
#pragma unroll
    for (int j = 0; j < 4; ++j) { const int n = (lane >> 3) + 8 * j; const LAS float* s = scr + (8 * c) * 33 + n;
        u32x4 o; o.x = cvtpk(s[0 * 33], s[1 * 33]); o.y = cvtpk(s[2 * 33], s[3 * 33]); o.z = cvtpk(s[4 * 33], s[5 * 33]); o.w = cvtpk(s[6 * 33], s[7 * 33]);
        st16_wt(WT + (size_t)(rowbase + n) * K + k0 + 8 * c, o); }
    LDS_WAIT(); asm volatile("" ::: "memory");
}
__device__ __forceinline__ void transpose_plain(const float* W, int K, int N, bf16_t* WT, int item, LAS float* scr, int lane) {
    const int nblk = N / 32, kb = item / nblk, nb = item % nblk; transpose_item(W, K, N, WT, 64 * kb, 32 * nb, 32 * nb, scr, lane);
}
__device__ __forceinline__ void cvt_copy(const float* __restrict__ src, bf16_t* __restrict__ dst, long n8, long gt, long ngt) {
    for (long i = gt; i < n8; i += ngt) { const f32x4 a = __builtin_nontemporal_load((const f32x4*)(src + i * 8)), b = __builtin_nontemporal_load((const f32x4*)(src + i * 8 + 4)); st16_wt(dst + i * 8, pg8::pack8(a, b)); }
}

__device__ __forceinline__ void phase0(const Params& p, unsigned char* lds) {
    const int tid = threadIdx.x, lane = tid & 63, wave = tid >> 6, G = gridDim.x;
    float* mod = (float*)(p.ws + OFF_MOD);
    float* red = (float*)lds;
    for (int it = blockIdx.x; it < (NMOD / 64) * 4; it += G) {
        const int cg = it >> 2, kq = it & 3, n0 = cg * 64, k0 = kq * 512 + wave * 64; const float* W = p.in[I_WMOD] + (size_t)k0 * NMOD + n0 + lane;
        const float s0 = silu_f(p.in[I_CCTX][k0 + lane]), s1 = silu_f(p.in[I_C][k0 + lane]), s2 = silu_f(p.in[I_C][DM + k0 + lane]);
        float a0 = 0.f, a1 = 0.f, a2 = 0.f;
#pragma unroll 16
        for (int kk = 0; kk < 64; ++kk) { const float w = __builtin_nontemporal_load(W + (size_t)kk * NMOD);
            a0 = fmaf(__uint_as_float(__builtin_amdgcn_readlane(__float_as_uint(s0), kk)), w, a0);
            a1 = fmaf(__uint_as_float(__builtin_amdgcn_readlane(__float_as_uint(s1), kk)), w, a1);
            a2 = fmaf(__uint_as_float(__builtin_amdgcn_readlane(__float_as_uint(s2), kk)), w, a2); }
        __syncthreads();
        red[(wave * 3 + 0) * 64 + lane] = a0; red[(wave * 3 + 1) * 64 + lane] = a1; red[(wave * 3 + 2) * 64 + lane] = a2;
        __syncthreads();
        if (tid < 192) { const int v = tid >> 6; float s = (kq == 0) ? p.in[I_BMOD][n0 + lane] : 0.f;
#pragma unroll
            for (int w = 0; w < 8; ++w) s += red[(w * 3 + v) * 64 + lane];
            atomicAdd(mod + (size_t)v * NMOD + n0 + lane, s); }
    }
}
__device__ __forceinline__ void phase1_weights(const Params& p, unsigned char* lds) {
    const int tid = threadIdx.x, lane = tid & 63, wave = tid >> 6, G = gridDim.x;
    unsigned char* ws = p.ws;
    LAS float* scr = (LAS float*)((LAS unsigned char*)lds + wave * 16384);
    const int gw = blockIdx.x * NWAVES + wave, NGW = G * NWAVES;
    constexpr int IT_IN = (DM / 64) * (INC / 32);
    for (int it = gw; it < IT_IN; it += NGW) transpose_plain(p.in[I_WIN], DM, INC, (bf16_t*)(ws + OFF_WIN), it, scr, lane);
    const long gt = (long)blockIdx.x * NTHREADS + tid, ngt = (long)G * NTHREADS;
    { u32x4* z = (u32x4*)((bf16_t*)(ws + OFF_WIN) + (size_t)INC * DM); const long nz = (long)(INCP - INC) * DM / 8;
      for (long i = gt; i < nz; i += ngt) z[i] = (u32x4){0u, 0u, 0u, 0u}; }
    cvt_copy(p.in[I_CNK], (bf16_t*)(ws + OFF_CNK), 1024L * 1024 / 8, gt, ngt);
    cvt_copy(p.in[I_CNV], (bf16_t*)(ws + OFF_CNV), 1024L * 1024 / 8, gt, ngt);
    cvt_copy(p.in[I_CKR], (bf16_t*)(ws + OFF_KRL) + (size_t)4096 * 64, 512L * 64 / 8, gt, ngt);
    cvt_copy(p.in[I_CKR] + 512 * 64, (bf16_t*)(ws + OFF_KRL) + (size_t)(4608 + 4096) * 64, 512L * 64 / 8, gt, ngt);
}

__device__ __forceinline__ void phase1(const Params& p) {
    const int tid = threadIdx.x, lane = tid & 63, wave = tid >> 6;
    const int gw = blockIdx.x * NWAVES + wave, NGW = gridDim.x * NWAVES;
    const float* mod = (const float*)(p.ws + OFF_MOD); bf16_t* H = (bf16_t*)(p.ws + OFF_R1);
    for (int ch = gw; ch < MTOK / 8; ch += NGW) {
        const int m0 = ch * 8; const int v = (m0 < NCTX) ? 0 : 1 + ((m0 - NCTX) >> 12);
        const float* sh = mod + (size_t)v * NMOD; const float* sc = sh + DM;
        const float* x = (m0 < NCTX) ? p.in[I_XP] + (size_t)m0 * DM : p.in[I_XS] + (size_t)(m0 - NCTX) * DM;
        f32x4 s[8], h[8];
#pragma unroll
        for (int j = 0; j < 8; ++j) { s[j] = *(const f32x4*)(sc + j * 256 + lane * 4) + 1.f; h[j] = *(const f32x4*)(sh + j * 256 + lane * 4); }
#pragma unroll 1
        for (int r = 0; r < 8; r += 2) {
            f32x4 a[8], b[8];
#pragma unroll
            for (int j = 0; j < 8; ++j) { a[j] = __builtin_nontemporal_load((const f32x4*)(x + (size_t)r * DM + j * 256 + lane * 4)); b[j] = __builtin_nontemporal_load((const f32x4*)(x + (size_t)(r + 1) * DM + j * 256 + lane * 4)); }
#pragma unroll
            for (int j = 0; j < 8; ++j) { const f32x4 ya = a[j] * s[j] + h[j], yb = b[j] * s[j] + h[j];
                u32x2 wa, wb; wa.x = cvtpk(ya.x, ya.y); wa.y = cvtpk(ya.z, ya.w); wb.x = cvtpk(yb.x, yb.y); wb.y = cvtpk(yb.z, yb.w);
                st8_wt(H + (size_t)(m0 + r) * DM + j * 256 + lane * 4, wa); st8_wt(H + (size_t)(m0 + r + 1) * DM + j * 256 + lane * 4, wb); }
        }
    }
}

__device__ __forceinline__ void phase3(const Params& p) {
    const int tid = threadIdx.x, lane = tid & 63, wave = tid >> 6;
    const int gw = blockIdx.x * NWAVES + wave, NGW = gridDim.x * NWAVES;
    bf16_t* Z = (bf16_t*)(p.ws + OFF_Z); bf16_t* KRL = (bf16_t*)(p.ws + OFF_KRL);
    float* sCKV = p.out + (size_t)MTOK * DM + (size_t)2 * NCTX * 1024;
    f32x4 gq0 = *(const f32x4*)(p.in[I_QAN] + lane * 8), gq1 = *(const f32x4*)(p.in[I_QAN] + lane * 8 + 4);
    f32x4 gk0 = *(const f32x4*)(p.in[I_KVAN] + lane * 8), gk1 = *(const f32x4*)(p.in[I_KVAN] + lane * 8 + 4);
    const float invf = exp2f(-(float)(lane & 15) * (13.287712379549449f / 16.f));
    {   bf16_t* CS = (bf16_t*)(p.ws + OFF_CCKVS); const float* src = p.in[I_CCKV];
        for (long i = (long)blockIdx.x * NTHREADS + tid; i < 1024L * 64; i += (long)gridDim.x * NTHREADS) { const long r = i >> 6, c8 = (i & 63) * 8;
            const f32x4 a = __builtin_nontemporal_load((const f32x4*)(src + r * 512 + c8)), b = __builtin_nontemporal_load((const f32x4*)(src + r * 512 + c8 + 4));
            st16_wt(CS + r * INCP + c8, pg8::pack8(a, b)); } }
    constexpr int R = 4;
    for (int m0 = gw; m0 < MTOK; m0 += R * NGW) {
        u32x4 wq[R], wk[R]; float xr[R];
#pragma unroll
        for (int r = 0; r < R; ++r) { const int m = m0 + r * NGW; bf16_t* z = Z + (size_t)m * INCP;
            wq[r] = *(const u32x4*)(z + ZQL + lane * 8); wk[r] = *(const u32x4*)(z + ZKVL + lane * 8); xr[r] = bf2f((short)z[ZKR + lane]); }
#pragma unroll
        for (int r = 0; r < R; ++r) { const int m = m0 + r * NGW; bf16_t* z = Z + (size_t)m * INCP;
            {   const u32x4 w = wq[r];
                f32x4 a = {bflo(w.x), bfhi(w.x), bflo(w.y), bfhi(w.y)}, b = {bflo(w.z), bfhi(w.z), bflo(w.w), bfhi(w.w)};
                float ss = a.x * a.x + a.y * a.y + a.z * a.z + a.w * a.w + b.x * b.x + b.y * b.y + b.z * b.z + b.w * b.w;
                const float rs = rsqrtf(wave_sum(ss) * (1.f / 512.f) + RMS_EPS);
                st16_wt(z + ZQL + lane * 8, pg8::pack8(a * rs * gq0, b * rs * gq1)); }
            {   const u32x4 w = wk[r];
                f32x4 a = {bflo(w.x), bfhi(w.x), bflo(w.y), bfhi(w.y)}, b = {bflo(w.z), bfhi(w.z), bflo(w.w), bfhi(w.w)};
                float ss = a.x * a.x + a.y * a.y + a.z * a.z + a.w * a.w + b.x * b.x + b.y * b.y + b.z * b.z + b.w * b.w;
                const float rs = rsqrtf(wave_sum(ss) * (1.f / 512.f) + RMS_EPS);
                a = a * rs * gk0; b = b * rs * gk1;
                st16_wt(z + ZKVL + lane * 8, pg8::pack8(a, b));
                if (m < NCTX) { __builtin_nontemporal_store(a, (f32x4*)(sCKV + (size_t)m * 512 + lane * 8)); __builtin_nontemporal_store(b, (f32x4*)(sCKV + (size_t)m * 512 + lane * 8 + 4)); } }
            if (m >= NCTX) {
                const int n = (m - NCTX) & 4095; const float pos = (lane < 32) ? (float)(n >> 6) : (float)(n & 63);
                const float x = xr[r]; const float xp = __shfl_xor(x, 16);
                const float ang = pos * invf, c = __cosf(ang), s = __sinf(ang);
                const float y = ((lane & 16) == 0) ? x * c - xp * s : x * c + xp * s;
                st2_wt(KRL + ((size_t)((m - NCTX) >> 12) * 4608 + n) * 64 + lane, (unsigned)(unsigned short)f2bf(y));
            }
        }
    }
}

template <bool H2>
__device__ __forceinline__ void ln_rows(const Params& p, const float* __restrict__ g, const float* __restrict__ b, unsigned char* lds, float* dst) {
    const int tid = threadIdx.x, lane = tid & 63, wave = tid >> 6;
    const float* mod = (const float*)(p.ws + OFF_MOD); bf16_t* Hb = (bf16_t*)(p.ws + OFF_R1);
    float* Lg = (float*)lds; float* Lb = Lg + DM; float* Ls = Lb + DM; float* Lh = Ls + DM;
    for (int ch = blockIdx.x; ch < MTOK / 64; ch += gridDim.x) {
        const int vv = (ch < 128) ? 0 : 1 + ((ch - 128) >> 6);
        const float* sh2 = mod + (size_t)vv * NMOD + 3 * DM; const float* sc2 = sh2 + DM;
        __syncthreads();
        { const int c = tid * 4; *(f32x4*)(Lg + c) = *(const f32x4*)(g + c); *(f32x4*)(Lb + c) = *(const f32x4*)(b + c);
          if constexpr (H2) { *(f32x4*)(Ls + c) = *(const f32x4*)(sc2 + c) + 1.f; *(f32x4*)(Lh + c) = *(const f32x4*)(sh2 + c); } }
        __syncthreads();
        const int m0 = ch * 64 + wave * 8;
        f32x4 nx[8];
#pragma unroll
        for (int j = 0; j < 8; ++j) nx[j] = *(const f32x4*)(p.out + (size_t)m0 * DM + j * 256 + lane * 4);
        for (int r = 0; r < 8; ++r) {
            const int m = m0 + r; const float* row = p.out + (size_t)m * DM; float* drow = dst + (size_t)m * DM;
            f32x4 v[8]; float s = 0.f;
#pragma unroll
            for (int j = 0; j < 8; ++j) { v[j] = nx[j]; s += (v[j].x + v[j].y) + (v[j].z + v[j].w); }
            if (r < 7) {
#pragma unroll
                for (int j = 0; j < 8; ++j) nx[j] = *(const f32x4*)(row + DM + j * 256 + lane * 4);
            }
            const float mean = wave_sum(s) * (1.f / DM); float s2 = 0.f;
#pragma unroll
            for (int j = 0; j < 8; ++j) { v[j] = v[j] - mean; s2 += (v[j].x * v[j].x + v[j].y * v[j].y) + (v[j].z * v[j].z + v[j].w * v[j].w); }
            const float rstd = rsqrtf(wave_sum(s2) * (1.f / DM) + LN_EPS);
#pragma unroll
            for (int j = 0; j < 8; ++j) { const int c = j * 256 + lane * 4;
                const f32x4 y = v[j] * rstd * *(const f32x4*)(Lg + c) + *(const f32x4*)(Lb + c);
                *(f32x4*)(drow + c) = y;
                if constexpr (H2) { const f32x4 h = y * *(const f32x4*)(Ls + c) + *(const f32x4*)(Lh + c);
                    u32x2 w; w.x = cvtpk(h.x, h.y); w.y = cvtpk(h.z, h.w); *(u32x2*)(Hb + (size_t)m * DM + c) = w; } }
        }
    }
}

__device__ __forceinline__ void late_weights(const Params& p, unsigned char* lds, int gw, int NGW) {
    const int tid = threadIdx.x, lane = tid & 63, wave = tid >> 6;
    LAS float* scr = (LAS float*)((LAS unsigned char*)lds + wave * 16384);
    constexpr int NB_GU = 2 * DFF / 32, IT_GU = (DM / 64) * NB_GU, IT_D = (DFF / 64) * (DM / 32);
    constexpr int IT_QB = (512 / 64) * (1536 / 32), IT_KVB = (512 / 64) * (2048 / 32), IT_O = (DM / 64) * (DM / 32);
    bf16_t* WGU = (bf16_t*)(p.ws + OFF_WGU); bf16_t* WD = (bf16_t*)(p.ws + OFF_WD);
    for (int it = gw; it < IT_QB + IT_KVB + IT_O; it += NGW) {
        int r = it;
        if (r < IT_QB) { transpose_plain(p.in[I_WQB], 512, 1536, (bf16_t*)(p.ws + OFF_WQB), r, scr, lane); continue; } r -= IT_QB;
        if (r < IT_KVB) { transpose_plain(p.in[I_WKVB], 512, 2048, (bf16_t*)(p.ws + OFF_WKVB), r, scr, lane); continue; } r -= IT_KVB;
        transpose_plain(p.in[I_WO], DM, DM, (bf16_t*)(p.ws + OFF_WO), r, scr, lane);
    }
    for (int it = gw; it < IT_GU + IT_D; it += NGW) {
        if (it < IT_GU) { const int kb = it / NB_GU, nb = it % NB_GU, n0 = nb * 32; const int j0 = (n0 < DFF) ? n0 : n0 - DFF;
            const int rowbase = (j0 >> 7) * 256 + ((n0 < DFF) ? 0 : 128) + (j0 & 127);
            transpose_item(p.in[I_WGU], DM, 2 * DFF, WGU, 64 * kb, n0, rowbase, scr, lane); }
        else transpose_plain(p.in[I_WDOWN], DFF, DM, WD, it - IT_GU, scr, lane);
    }
}

__device__ __forceinline__ void phase5(const Params& p, unsigned char* lds_, int modes = 15) {
    char* lds = (char*)lds_;
    const int G = gridDim.x, bx = blockIdx.x;
    const int vcu = (G % 8 == 0) ? (bx % 8) * (G / 8) + bx / 8 : bx;
    const bf16_t* Z = (const bf16_t*)(p.ws + OFF_Z); const bf16_t* Q = (const bf16_t*)(p.ws + OFF_Q); const bf16_t* KV = (const bf16_t*)(p.ws + OFF_KV);
    const bf16_t* CNK = (const bf16_t*)(p.ws + OFF_CNK); const bf16_t* CNV = (const bf16_t*)(p.ws + OFF_CNV);
    const bf16_t* KRL = (const bf16_t*)(p.ws + OFF_KRL);
    bf16_t* MIX = (bf16_t*)(p.ws + OFF_R1);
    if (modes & 8) for (int u = vcu; u < 256; u += G) { const int bh = u >> 4, qb = u & 15, b = bh >> 3, h = bh & 7;
        const size_t t0 = (size_t)NCTX + (size_t)b * 4096;
        const bf16_t* kv = KV + ((size_t)NCTX + (size_t)b * 4608) * 2048 + h * 256;
        att::Seg s0{kv, kv + 128, KRL + (size_t)b * 4608 * 64, 2048, 64};
        att::attn_unit<192, true, false>(Q + (t0 + qb * 256) * 1536 + h * 192, 1536, s0, 72, s0, 72, MIX + (t0 + qb * 256) * DM + 1024 + h * 128, lds, qb * 256, 0, nullptr); }
    if (modes & 4) for (int u = vcu; u < 256; u += G) { const int bh = u >> 4, qb = u & 15, b = bh >> 3, h = bh & 7;
        const size_t t0 = (size_t)NCTX + (size_t)b * 4096; const int r0 = qb * 4;
        const int kr0 = (r0 == 0) ? 0 : (r0 == 60 ? 56 : r0 - 4), NT0 = (r0 == 0 || r0 == 60) ? 8 : 11;
        att::Seg s0{Z + (t0 + kr0 * 64) * INCP + ZK + h * 128, Z + (t0 + kr0 * 64) * INCP + ZV + h * 128, nullptr, INCP, 0};
        att::Seg s1{CNK + (size_t)b * 512 * 1024 + h * 128, CNV + (size_t)b * 512 * 1024 + h * 128, nullptr, 1024, 0};
        att::attn_unit<128, true, true>(Z + (t0 + qb * 256) * INCP + ZQ + h * 128, INCP, s0, NT0, s1, NT0 + 8, MIX + (t0 + qb * 256) * DM + h * 128, lds, qb * 256, kr0, p.in[I_RPB] + h * 465); }
    if (modes & 2) for (int u = vcu; u < 256; u += G) { const int b = u >> 3, h = u & 7; const size_t t0 = (size_t)b * 256;
        att::Seg s0{KV + t0 * 2048 + h * 256, KV + t0 * 2048 + h * 256 + 128, Z + t0 * INCP + ZKR, 2048, INCP};
        att::attn_unit<192, false, true>(Q + t0 * 1536 + h * 192, 1536, s0, 4, s0, 4, MIX + t0 * DM + 1024 + h * 128, lds, 0, 0, nullptr); }
    if (modes & 1) for (int u = vcu; u < 256; u += G) { const int b = u >> 3, h = u & 7; const size_t t0 = (size_t)b * 256;
        att::Seg s0{Z + t0 * INCP + ZK + h * 128, Z + t0 * INCP + ZV + h * 128, nullptr, INCP, 0};
        att::attn_unit<128, false, true>(Z + t0 * INCP + ZQ + h * 128, INCP, s0, 4, s0, 4, MIX + t0 * DM + h * 128, lds, 0, 0, nullptr); }
}

#define XB_TMO      128
#define XB_XCNT(j)  (256  + 64 * (j))
#define XB_XSUB(j)  (1280 + 64 * (j))
#define XB_XGEN(j)  (2304 + 64 * (j))
#define XB_TOP      3328
#define XB_TOPGEN   3392
#define XCD_BAR_WORDS 3456
#define XB_SPIN_CAP (1u << 18)
__device__ __forceinline__ unsigned xb_ld(unsigned* p)              { return __hip_atomic_load(p, __ATOMIC_RELAXED, __HIP_MEMORY_SCOPE_AGENT); }
__device__ __forceinline__ unsigned xb_add(unsigned* p, unsigned v) { return __hip_atomic_fetch_add(p, v, __ATOMIC_RELAXED, __HIP_MEMORY_SCOPE_AGENT); }
__device__ __forceinline__ unsigned xb_xcc_id() { return (unsigned)__builtin_amdgcn_s_getreg((3 << 11) | 20) & 0xFu; }
#define XB_SPIN(cond, bar) do { unsigned _sp = 0; while (cond) { __builtin_amdgcn_s_sleep(1); \
    if ((++_sp & 255u) == 0u) { if (xb_ld(&(bar)[XB_TMO])) break; if (_sp > XB_SPIN_CAP) { atomicAdd(&(bar)[XB_TMO], 1u); break; } } } } while (0)
struct XcdBarrier { unsigned* bar; unsigned x; volatile LAS unsigned* st; };
__device__ __forceinline__ XcdBarrier xcd_barrier_post(unsigned* bar, volatile LAS unsigned* st) {
    XcdBarrier b; b.bar = bar; b.x = xb_xcc_id(); b.st = st;
    if (threadIdx.x == 0) (void)xb_add(&bar[XB_XCNT(b.x)], 1u);
    return b;
}
__device__ __forceinline__ void xcd_barrier_complete(unsigned* bar, unsigned x, unsigned& nloc, unsigned& nx) {
    const unsigned G = gridDim.x * gridDim.y * gridDim.z;
    unsigned sum, cnt, mine, sp = 0u;
    for (;;) {
        sum = 0u; cnt = 0u; mine = 0u;
#pragma unroll
        for (unsigned j = 0; j < 16; ++j) { const unsigned c = xb_ld(&bar[XB_XCNT(j)]); sum += c; cnt += (c > 0u) ? 1u : 0u; mine = (j == x) ? c : mine; }
        if (sum == G) break;
        __builtin_amdgcn_s_sleep(1);
        if ((++sp & 255u) == 0u) { if (xb_ld(&bar[XB_TMO])) break; if (sp > XB_SPIN_CAP) { atomicAdd(&bar[XB_TMO], 1u); break; } }
    }
    nloc = mine > 0u ? mine : 1u; nx = cnt > 0u ? cnt : 1u;
}
__device__ __forceinline__ void xcd_barrier(const XcdBarrier& b) {
    asm volatile("s_waitcnt vmcnt(0)" ::: "memory");
    __syncthreads();
    if (threadIdx.x == 0) {
        unsigned* bar = b.bar;
        __builtin_amdgcn_s_waitcnt(0);
        unsigned nloc = b.st[0], nx = b.st[1];
        if (nloc == 0u) { xcd_barrier_complete(bar, b.x, nloc, nx); b.st[0] = nloc; b.st[1] = nx; }
        const unsigned old = xb_add(&bar[XB_XSUB(b.x)], 1u);
        const unsigned gen = old / nloc;
        if (old + 1u == (gen + 1u) * nloc) {
            __builtin_amdgcn_fence(__ATOMIC_RELEASE, "agent");
            asm volatile("s_waitcnt vmcnt(0)" ::: "memory");
            const unsigned og = xb_add(&bar[XB_TOP], 1u);
            const unsigned tg = og / nx;
            if (og + 1u == (tg + 1u) * nx) xb_add(&bar[XB_TOPGEN], 1u);
            else XB_SPIN(xb_ld(&bar[XB_TOPGEN]) == tg, bar);
            __builtin_amdgcn_fence(__ATOMIC_ACQUIRE, "agent");
            xb_add(&bar[XB_XGEN(b.x)], 1u);
            asm volatile("s_waitcnt vmcnt(0)" ::: "memory");
        } else {
            XB_SPIN(xb_ld(&bar[XB_XGEN(b.x)]) == gen, bar);
            __builtin_amdgcn_fence(__ATOMIC_ACQUIRE, "agent");
            asm volatile("s_waitcnt vmcnt(0)" ::: "memory");
        }
    }
    __syncthreads();
}

__global__ void __launch_bounds__(NTHREADS, 2) mega_fwd(Params p) {
    extern __shared__ __attribute__((aligned(16))) unsigned char lds[];
    cg::grid_group grid = cg::this_grid();
    const int lo = p.ph_lo, hi = p.ph_hi, G = gridDim.x, bx = blockIdx.x;
    unsigned char* ws = p.ws;
    LAS unsigned char* ldsl = (LAS unsigned char*)lds;
#define IN(k) (lo <= (k) && (k) < hi)
#define SEAM(k) do { if (IN(k) && IN((k) + 1)) xcd_barrier(xbar); } while (0)
    volatile LAS unsigned* xst = (volatile LAS unsigned*)(ldsl + LDS_BYTES - 64);
    if (threadIdx.x == 0) { xst[0] = 0u; xst[1] = 0u; }
    unsigned* barw = (unsigned*)(ws + OFF_BAR);
    if (p.never) grid.sync();
    XcdBarrier xbar = xcd_barrier_post(barw, xst);
    if (IN(0)) phase0(p, lds);
    SEAM(0);
    if (IN(1)) { phase1_weights(p, lds); phase1(p); }
    SEAM(1);
    if (IN(2)) {
        pg8::Gemm g{(const bf16_t*)(ws + OFF_R1), (const bf16_t*)(ws + OFF_WIN), MTOK, INCP, DM, DM}; pg8::StaticOrder S; S.init(MTOK, INCP, G, bx);
        float* sK = p.out + (size_t)MTOK * DM; float* sV = sK + (size_t)NCTX * 1024; float* sKR = sV + (size_t)NCTX * 1024 + (size_t)NCTX * 512;
        pg8::EpiInProj E{(bf16_t*)(ws + OFF_Z), sK, sV, sKR};
        pg8::gemm_phase<false>(ldsl, g, S, E);
        if (PROBE_DUP == 2) pg8::gemm_phase<false>(ldsl, g, S, E);
        const int wave = threadIdx.x >> 6;
        if (G == 256) { if (bx >= 64) late_weights(p, lds, (bx - 64) * NWAVES + wave, 192 * NWAVES); }
        else late_weights(p, lds, bx * NWAVES + wave, G * NWAVES);
    }
    SEAM(2);
    if (IN(3)) phase3(p);
    SEAM(3);
    if (IN(4)) {
        pg8::Gemm g{(const bf16_t*)(ws + OFF_Z), (const bf16_t*)(ws + OFF_WKVB), MTOK, 2048, 512, INCP};
        pg8::P4Order S; S.so.init(MTOK, 14 * 256, G, bx); S.ws = (const char*)ws; S.G = G; S.c = bx;
        pg8::EpiP4 E{(bf16_t*)(ws + OFF_Q), (bf16_t*)(ws + OFF_KV)};
        pg8::gemm_phase<false>(ldsl, g, S, E);
    }
    SEAM(4);
    if (IN(5)) { phase5(p, lds); if (PROBE_DUP >= 50) phase5(p, lds, PROBE_DUP - 50); }
    SEAM(5);
    if (IN(6)) {
        pg8::Gemm g{(const bf16_t*)(ws + OFF_R1), (const bf16_t*)(ws + OFF_WO), MTOK, DM, DM, DM}; pg8::PanelOrder S{bx};
        pg8::EpiResidLN<true, false, true> E{p.in[I_XP], p.in[I_XS], nullptr, nullptr, (bf16_t*)(ws + OFF_X1B), (const float*)(ws + OFF_MOD) + 2 * DM, p.in[I_LN1G], p.in[I_LN1B],
                                (const float*)(ws + OFF_MOD) + 3 * DM, (bf16_t*)(ws + OFF_R1), (float*)(ws + OFF_STAT), (unsigned*)(ws + OFF_FLAG), ldsl + 131072};
        pg8::gemm_phase<true>(ldsl, g, S, E);
    }
    SEAM(6);
    if (IN(7)) {
        pg8::Gemm g{(const bf16_t*)(ws + OFF_R1), (const bf16_t*)(ws + OFF_WGU), MTOK, 2 * DFF, DM, DM}; pg8::StaticOrder S; S.init(MTOK, 2 * DFF, G, bx);
        pg8::EpiSwiGLU E{(bf16_t*)(ws + OFF_ACT)};
        pg8::gemm_phase<false>(ldsl, g, S, E);
        if (PROBE_DUP == 8) pg8::gemm_phase<false>(ldsl, g, S, E);
    }
    SEAM(7);
    if (IN(8)) {
        pg8::Gemm g{(const bf16_t*)(ws + OFF_ACT), (const bf16_t*)(ws + OFF_WD), MTOK, DM, DFF, DFF}; pg8::PanelOrder S{bx};
        pg8::EpiResidLN<false, true, false> E{nullptr, nullptr, (const bf16_t*)(ws + OFF_X1B), p.out, nullptr, (const float*)(ws + OFF_MOD) + 5 * DM, p.in[I_LN2G], p.in[I_LN2B], nullptr, nullptr,
                                 (float*)(ws + OFF_STAT) + (size_t)64 * 8 * 256 * 2, (unsigned*)(ws + OFF_FLAG) + 64, ldsl + 131072};
        pg8::gemm_phase<true>(ldsl, g, S, E);
    }
#undef IN
#undef SEAM
}

constexpr int NPHASE = 9;
extern "C" void kernel_launch(void* const* d_in, const int* in_sizes, int n_in, void* d_out, int out_size, void* d_ws, size_t ws_size, hipStream_t stream) {
    static int grid = 0;
    if (grid == 0) {
        if (n_in != 23 || ws_size < WS_NEED) { fprintf(stderr, "kernel_launch: expected 23 inputs and >= %zu bytes of workspace; got %d, %zu\n", (size_t)WS_NEED, n_in, ws_size); grid = -1; return; }
        int dev = 0, cus = 0, per_cu = 0;
        if (hipGetDevice(&dev) != hipSuccess || hipDeviceGetAttribute(&cus, hipDeviceAttributeMultiprocessorCount, dev) != hipSuccess) { grid = -1; return; }
        if (hipFuncSetAttribute((const void*)mega_fwd, hipFuncAttributeMaxDynamicSharedMemorySize, LDS_BYTES) != hipSuccess) { fprintf(stderr, "kernel_launch: hipFuncSetAttribute failed\n"); grid = -1; return; }
        if (hipOccupancyMaxActiveBlocksPerMultiprocessor(&per_cu, (const void*)mega_fwd, NTHREADS, LDS_BYTES) != hipSuccess || per_cu < 1) { fprintf(stderr, "kernel_launch: occupancy query gave %d\n", per_cu); grid = -1; return; }
        grid = cus * per_cu;
        if (grid > 256) grid = 256;
        if (grid != 256) { fprintf(stderr, "kernel_launch: this kernel needs a 256-workgroup co-resident grid (got %d)\n", grid); grid = -1; return; }
        fprintf(stderr, "kernel_launch: grid %d (cus %d x %d)\n", grid, cus, per_cu);
    }
    if (grid < 0) return;
    Params p{};
    for (int i = 0; i < 23; ++i) p.in[i] = (const float*)d_in[i];
    p.out = (float*)d_out; p.ws = (unsigned char*)d_ws;
    if (hipMemsetAsync((char*)d_ws + OFF_BAR, 0, CTL_BYTES, stream) != hipSuccess) { fprintf(stderr, "kernel_launch: memset failed\n"); return; }
#if MK_MULTI
    for (int k = 0; k < NPHASE; ++k) { p.ph_lo = k; p.ph_hi = k + 1; hipLaunchKernelGGL(mega_fwd, dim3(grid), dim3(NTHREADS), LDS_BYTES, stream, p); }
#else
    p.ph_lo = 0; p.ph_hi = NPHASE;
    void* args[] = {&p};
    hipError_t e = hipLaunchCooperativeKernel((const void*)mega_fwd, dim3(grid), dim3(NTHREADS), args, LDS_BYTES, stream);
    if (e != hipSuccess) fprintf(stderr, "kernel_launch: cooperative launch failed: %s (grid %d)\n", hipGetErrorString(e), grid);
#endif
}
```

```cpp
#include <hip/hip_runtime.h>
#include <hip/hip_cooperative_groups.h>
#include <cstdio>
#include <cstdint>
namespace cg = cooperative_groups;

#ifndef PROBE_DUP
#define PROBE_DUP -1
#endif
#ifndef MK_MULTI
#define MK_MULTI 0
#endif

typedef unsigned short bf16_t;
typedef short bf16x8 __attribute__((ext_vector_type(8)));
typedef short s16x4 __attribute__((ext_vector_type(4)));
typedef float f32x4 __attribute__((ext_vector_type(4)));
typedef float f32x16 __attribute__((ext_vector_type(16)));
typedef unsigned u32x4 __attribute__((ext_vector_type(4)));
typedef unsigned u32x2 __attribute__((ext_vector_type(2)));
#define LAS __attribute__((address_space(3)))

constexpr int DM = 2048, NCTX = 8192, MTOK = 16384, INC = 4160, INCP = 4352, DFF = 5632, NMOD = 12288;
constexpr int ZQ = 0, ZK = 1024, ZV = 2048, ZQL = 3072, ZKVL = 3584, ZKR = 4096;
constexpr float ALPHA = 1.189207115002721f;
constexpr float LN_EPS = 1e-5f, RMS_EPS = 1e-6f;
constexpr int NTHREADS = 512, NWAVES = 8;
constexpr int LDS_BYTES = 147456;

constexpr size_t MiB = 1u << 20;
constexpr size_t KiB = 1u << 10;
constexpr size_t OFF_MOD = 6 * MiB + 512 * KiB + 32 * KiB;
constexpr size_t OFF_CNK = 256 * KiB;
constexpr size_t OFF_CNV = OFF_CNK + 2 * MiB;
constexpr size_t OFF_CCKV = OFF_CNV + 2 * MiB;
constexpr size_t OFF_KRL = OFF_CCKV + 1 * MiB;
constexpr size_t OFF_BAR = 6 * MiB + 512 * KiB;
constexpr size_t OFF_WIN = 7 * MiB;
constexpr size_t OFF_CCKVS = OFF_WIN;
constexpr size_t OFF_WQB = 24 * MiB;
constexpr size_t OFF_WKVB = 26 * MiB;
constexpr size_t OFF_WO = 28 * MiB;
constexpr size_t OFF_R1 = 36 * MiB;
constexpr size_t OFF_Z = 100 * MiB;
constexpr size_t OFF_Q = 236 * MiB;
constexpr size_t OFF_KV = 284 * MiB;
constexpr size_t OFF_KVL = 316 * MiB;
constexpr size_t OFF_X1B = OFF_KV;
constexpr size_t OFF_ACT = OFF_Z;
constexpr size_t OFF_WGU = 352 * MiB;
constexpr size_t OFF_WD = 396 * MiB;
constexpr size_t OFF_STAT = 418 * MiB;
constexpr size_t OFF_FLAG = OFF_BAR + 16 * KiB;
constexpr size_t CTL_BYTES = 32 * KiB + 3 * NMOD * 4;
constexpr size_t WS_NEED = 420 * MiB;
static_assert(OFF_KRL + 2 * 4608 * 64 * 2 <= OFF_BAR && OFF_BAR + CTL_BYTES <= OFF_WIN && OFF_KVL == OFF_KV + (size_t)NCTX * 2048 * 2, "ws map");

__device__ __forceinline__ unsigned cvtpk(float lo, float hi) { unsigned r; asm("v_cvt_pk_bf16_f32 %0, %1, %2" : "=v"(r) : "v"(lo), "v"(hi)); return r; }
__device__ __forceinline__ float bflo(unsigned w) { return __uint_as_float(w << 16); }
__device__ __forceinline__ float bfhi(unsigned w) { return __uint_as_float(w & 0xffff0000u); }
__device__ __forceinline__ float bf2f(short h) { return __uint_as_float(((unsigned)(unsigned short)h) << 16); }
__device__ __forceinline__ short f2bf(float f) { return (short)(cvtpk(f, 0.f) & 0xffffu); }
__device__ __forceinline__ float wave_sum(float v) {
#pragma unroll
    for (int o = 1; o < 64; o <<= 1) v += __shfl_xor(v, o);
    return v;
}
__device__ __forceinline__ float silu_f(float x) { return x * __builtin_amdgcn_rcpf(1.f + __expf(-x)); }
#define LDS_WAIT() asm volatile("s_waitcnt lgkmcnt(0)" ::: "memory")
__device__ __forceinline__ void st16_wt(void* p, u32x4 v) { asm volatile("global_store_dwordx4 %0, %1, off sc1\n\ts_nop 2" :: "v"(p), "v"(v) : "memory"); }
__device__ __forceinline__ void st8_wt(void* p, u32x2 v) { asm volatile("global_store_dwordx2 %0, %1, off sc1" :: "v"(p), "v"(v) : "memory"); }

namespace pg8 {
constexpr int BM = 256, BK = 64, HALF = 128, HTB = HALF * BK * 2, NXCD = 8, WGM = 8;
__host__ __device__ __forceinline__ int lds_byte(int r, int c) { const int st = (r >> 4) * 2 + (c >> 5), rr = r & 15, cc = c & 31, ob = rr * 64 + cc * 2; return st * 1024 + (ob ^ (((ob >> 9) & 1) << 5)); }
__host__ __device__ __forceinline__ void stage_rc(int b, int& R, int& C) { const int st = b / 1024, sb = b % 1024, swz = sb ^ (((sb >> 9) & 1) << 5); R = (st >> 1) * 16 + swz / 64; C = (st & 1) * 32 + (swz % 64) / 2; }
__host__ __device__ __forceinline__ int perm32(int rho) { const int n = rho >> 4, i = rho & 15; return 8 * (i >> 2) + 4 * n + (i & 3); }

struct Unit { int pm, pn, kind; };
struct Gemm { const bf16_t* A; const bf16_t* Bt; int M, N, K, lda; };

struct StaticOrder {
    int nM, nN, nwg, G, c;
    __device__ __forceinline__ void init(int M, int N, int G_, int c_) { nM = M / BM; nN = N / BM; nwg = nM * nN; G = G_; c = c_; }
    __device__ __forceinline__ bool next(int i, Unit& u) const { return map((long)i * G + c, u); }
    __device__ __forceinline__ const char* aptr(const Gemm& g, const Unit& u, size_t tstepA) const { return (const char*)g.A + (size_t)u.pm * tstepA; }
    __device__ __forceinline__ const char* bptr(const Gemm& g, const Unit& u, size_t tstepB) const { return (const char*)g.Bt + (size_t)u.pn * tstepB; }
    __device__ __forceinline__ bool map(long L, Unit& u) const {
        u.kind = 0; if (L >= nwg) return false;
        int wgid = (int)L; { const int q = nwg / NXCD, r = nwg % NXCD, xcd = wgid % NXCD, off = wgid / NXCD; wgid = (xcd < r ? xcd * (q + 1) : r * (q + 1) + (xcd - r) * q) + off; }
        const int nig = WGM * nN, gid = wgid / nig, fm = gid * WGM, gsz = (nM - fm) < WGM ? (nM - fm) : WGM;
        u.pm = fm + ((wgid % nig) % gsz); u.pn = (wgid % nig) / gsz; return true;
    }
};

template <bool ALIGN_EPI, class Epi, class Sched>
__device__ __forceinline__ void gemm_phase(LAS unsigned char* lds, const Gemm g, const Sched& S, const Epi& E) {
    const int tid = threadIdx.x, wid = __builtin_amdgcn_readfirstlane(tid >> 6), lane = tid & 63, wr = wid >> 2, wc = wid & 3, fr = lane & 15, fq = lane >> 4;
    const int K = g.K, nt = K / BK, lda = g.lda;
    unsigned voffA[2], voffB[2];
#pragma unroll
    for (int i = 0; i < 2; ++i) { int R, C; stage_rc(tid * 16 + i * 8192, R, C); const int Rb = (R & ~31) + perm32(R & 31);
        voffA[i] = (unsigned)(R * lda + C) * 2u; voffB[i] = (unsigned)(Rb * K + C) * 2u; }
    const size_t kstep = (size_t)(BK * 2);
    const size_t hstepA = (size_t)HALF * lda * 2, hstepB = (size_t)HALF * K * 2;
    const size_t tstepA = 2 * hstepA, tstepB = 2 * hstepB;
    const unsigned ldsw = (unsigned)wid * 1024u;
    const int aoff = lds_byte(wr * 64 + fr, fq * 8), boff = lds_byte(wc * 32 + fr, fq * 8);
#define PG8_SA(b, h) (((b) * 2 + (h)) * HTB)
#define PG8_SB(b, h) ((4 + (b) * 2 + (h)) * HTB)
#define PG8_STAGE(bufoff, gbase, voff) do { _Pragma("unroll") for (int _i = 0; _i < 2; ++_i) \
        __builtin_amdgcn_global_load_lds((const unsigned*)((const char*)(gbase) + (voff)[_i]), (LAS unsigned*)(lds + (bufoff) + ldsw + _i * 8192), 16, 0, 0); } while (0)
#define PG8_LDA(dst, b, h) do { _Pragma("unroll") for (int m = 0; m < 4; ++m) _Pragma("unroll") for (int k = 0; k < 2; ++k) dst[m][k] = *(const LAS bf16x8*)(lds + PG8_SA(b, h) + aoff + m * 2048 + k * 1024); } while (0)
#define PG8_LDB(dst, b, h) do { _Pragma("unroll") for (int n = 0; n < 2; ++n) _Pragma("unroll") for (int k = 0; k < 2; ++k) dst[n][k] = *(const LAS bf16x8*)(lds + PG8_SB(b, h) + boff + n * 2048 + k * 1024); } while (0)
#define PG8_MMA(ai, bj, At, Bt) do { __builtin_amdgcn_s_setprio(1); _Pragma("unroll") for (int m = 0; m < 4; ++m) _Pragma("unroll") for (int n = 0; n < 2; ++n) _Pragma("unroll") for (int k = 0; k < 2; ++k) \
        acc[ai][bj][m][n] = __builtin_amdgcn_mfma_f32_16x16x32_bf16(Bt[n][k], At[m][k], acc[ai][bj][m][n], 0, 0, 0); __builtin_amdgcn_s_setprio(0); } while (0)
#define PG8_WAIT_V(n) asm volatile("s_waitcnt vmcnt(" #n ")" ::: "memory")
#define PG8_WAIT_L(n) asm volatile("s_waitcnt lgkmcnt(" #n ")" ::: "memory")
#define PG8_BAR __builtin_amdgcn_s_barrier()
#define PG8_SCHED __builtin_amdgcn_sched_barrier(0)
    Unit cur, nxt; int ui = 0;
    if (!S.next(0, cur)) return;
    f32x4 acc[2][2][4][2];
    int est = 0;
    if constexpr (Epi::HAS_INIT) est = E.init(acc, cur, wr, wc);
    else {
#pragma unroll
    for (int a = 0; a < 2; ++a)
#pragma unroll
        for (int b = 0; b < 2; ++b)
#pragma unroll
            for (int m = 0; m < 4; ++m)
#pragma unroll
                for (int n = 0; n < 2; ++n) acc[a][b][m][n] = (f32x4){0.f, 0.f, 0.f, 0.f};
    }
    bf16x8 At[4][2], B0[2][2], B1[2][2];
    const char* cA = S.aptr(g, cur, tstepA); const char* cB = S.bptr(g, cur, tstepB);
    PG8_STAGE(PG8_SB(0, 0), cB, voffB); PG8_STAGE(PG8_SB(0, 1), cB + hstepB, voffB); PG8_STAGE(PG8_SA(0, 0), cA, voffA); PG8_STAGE(PG8_SA(0, 1), cA + hstepA, voffA);
    if (wr == 1) PG8_BAR;
    PG8_WAIT_V(2); PG8_BAR;
    PG8_STAGE(PG8_SB(1, 0), cB + kstep, voffB); PG8_STAGE(PG8_SA(1, 0), cA + kstep, voffA); PG8_STAGE(PG8_SB(1, 1), cB + hstepB + kstep, voffB);
    PG8_WAIT_V(6); PG8_BAR;
    for (;;) {
        const bool has_next = S.next(ui + 1, nxt);
        const char* nA = has_next ? S.aptr(g, nxt, tstepA) : cA; const char* nB = has_next ? S.bptr(g, nxt, tstepB) : cB;
        for (int t = 0; t < nt; t += 2) {
            const bool last = (t == nt - 2);
            const char* a1 = cA + (size_t)(t + 1) * kstep;
            const char* a2 = last ? nA : cA + (size_t)(t + 2) * kstep; const char* b2 = last ? nB : cB + (size_t)(t + 2) * kstep;
            const char* a3 = a2 + kstep; const char* b3 = b2 + kstep;
            PG8_LDB(B0, 0, 0); PG8_LDB(B1, 0, 1); PG8_SCHED; PG8_LDA(At, 0, 0); PG8_STAGE(PG8_SA(1, 1), a1 + hstepA, voffA);
            PG8_WAIT_V(8); PG8_WAIT_L(0); PG8_BAR; PG8_MMA(0, 0, At, B0); PG8_MMA(0, 1, At, B1); PG8_BAR; PG8_SCHED;
            PG8_LDA(At, 0, 1); PG8_STAGE(PG8_SB(0, 0), b2, voffB); PG8_STAGE(PG8_SB(0, 1), b2 + hstepB, voffB); PG8_STAGE(PG8_SA(0, 0), a2, voffA);
            PG8_WAIT_V(8); PG8_WAIT_L(0); PG8_BAR; PG8_MMA(1, 0, At, B0); PG8_MMA(1, 1, At, B1); PG8_BAR; PG8_SCHED;
            PG8_LDB(B0, 1, 0); PG8_LDB(B1, 1, 1); PG8_SCHED; PG8_LDA(At, 1, 0); PG8_STAGE(PG8_SA(0, 1), a2 + hstepA, voffA);
            PG8_WAIT_V(8); PG8_WAIT_L(0); PG8_BAR; PG8_MMA(0, 0, At, B0); PG8_MMA(0, 1, At, B1); PG8_BAR; PG8_SCHED;
            PG8_LDA(At, 1, 1); PG8_STAGE(PG8_SB(1, 0), b3, voffB); PG8_STAGE(PG8_SB(1, 1), b3 + hstepB, voffB); PG8_STAGE(PG8_SA(1, 0), a3, voffA);
            PG8_WAIT_V(8); PG8_WAIT_L(0); PG8_BAR; PG8_MMA(1, 0, At, B0); PG8_MMA(1, 1, At, B1); PG8_BAR; PG8_SCHED;
        }
        if constexpr (ALIGN_EPI) { if (wr == 0) PG8_BAR; }
        if constexpr (Epi::HAS_INIT) E(acc, cur, wr, wc, fr, fq, est); else E(acc, cur, wr, wc, fr, fq);
        if (!has_next) break;
        if constexpr (Epi::HAS_INIT) est = E.init(acc, nxt, wr, wc);
        else {
#pragma unroll
        for (int a = 0; a < 2; ++a)
#pragma unroll
            for (int b = 0; b < 2; ++b)
#pragma unroll
                for (int m = 0; m < 4; ++m)
#pragma unroll
                    for (int n = 0; n < 2; ++n) acc[a][b][m][n] = (f32x4){0.f, 0.f, 0.f, 0.f};
        }
        cur = nxt; cA = nA; cB = nB; ++ui;
        if constexpr (ALIGN_EPI) { if (wr == 1) PG8_BAR; }
    }
    PG8_WAIT_V(0);
    if constexpr (!ALIGN_EPI) { if (wr == 0) PG8_BAR; }
    PG8_BAR;
#undef PG8_SA
#undef PG8_SB
#undef PG8_STAGE
#undef PG8_LDA
#undef PG8_LDB
#undef PG8_MMA
#undef PG8_WAIT_V
#undef PG8_WAIT_L
#undef PG8_BAR
#undef PG8_SCHED
}

__device__ __forceinline__ u32x4 pack8(const f32x4 v0, const f32x4 v1) { u32x4 w; w.x = cvtpk(v0[0], v0[1]); w.y = cvtpk(v0[2], v0[3]); w.z = cvtpk(v1[0], v1[1]); w.w = cvtpk(v1[2], v1[3]); return w; }

struct EpiBf16 {
    static constexpr bool HAS_INIT = false;
    bf16_t* O; int ldc; int mode;
    __device__ __forceinline__ void operator()(const f32x4 (&acc)[2][2][4][2], const Unit& u, int wr, int wc, int fr, int fq) const {
        int rb = u.pm * BM;
        if (mode == 1) { if (u.pm >= 32) { const int b = (u.pm - 32) >> 4; rb += b * 512; } }
        else if (mode == 2) { const int b = u.pm >> 1; rb = NCTX + b * 4608 + 4096 + (u.pm & 1) * BM; }
        const int row0 = rb + wr * 64 + fr, col0 = u.pn * BM + wc * 32 + 8 * fq;
#pragma unroll
        for (int ai = 0; ai < 2; ++ai)
#pragma unroll
            for (int m = 0; m < 4; ++m) { bf16_t* rowp = O + (size_t)(row0 + ai * HALF + m * 16) * ldc + col0;
#pragma unroll
                for (int bj = 0; bj < 2; ++bj) st16_wt(rowp + bj * HALF, pack8(acc[ai][bj][m][0], acc[ai][bj][m][1])); }
    }
};
struct P4Order {
    StaticOrder so; const char* ws; int G, c;
    __device__ __forceinline__ bool next(int i, Unit& u) const {
        const long L = (long)i * G + c;
        if (L < 896) { so.map(L, u); if (u.pn < 8) u.kind = 1; else { u.kind = 0; u.pn -= 8; } return true; }
        if (L < 928) { const int idx = (int)L - 896; u.pm = idx >> 3; u.pn = idx & 7; u.kind = 2; return true; }
        return false;
    }
    __device__ __forceinline__ const char* aptr(const Gemm&, const Unit& u, size_t tstepA) const {
        const size_t off = (u.kind == 1) ? (OFF_Z + (size_t)ZKVL * 2) : ((u.kind == 0) ? (OFF_Z + (size_t)ZQL * 2) : OFF_CCKVS);
        return ws + off + (size_t)u.pm * tstepA; }
    __device__ __forceinline__ const char* bptr(const Gemm&, const Unit& u, size_t tstepB) const {
        const size_t off = (u.kind == 0) ? OFF_WQB : OFF_WKVB;
        return ws + off + (size_t)u.pn * tstepB; }
};
struct EpiP4 {
    static constexpr bool HAS_INIT = false;
    bf16_t* Q; bf16_t* KV;
    __device__ __forceinline__ void operator()(const f32x4 (&acc)[2][2][4][2], const Unit& u, int wr, int wc, int fr, int fq) const {
        if (u.kind == 0) { EpiBf16 e{Q, 1536, 0}; e(acc, u, wr, wc, fr, fq); } else { EpiBf16 e{KV, 2048, u.kind}; e(acc, u, wr, wc, fr, fq); }
    }
};
struct EpiInProj {
    static constexpr bool HAS_INIT = false;
    bf16_t* Z; float* sK; float* sV; float* sKR;
    __device__ __forceinline__ void operator()(const f32x4 (&acc)[2][2][4][2], const Unit& u, int wr, int wc, int fr, int fq) const {
        const int row0 = u.pm * BM + wr * 64 + fr, col0 = u.pn * BM + wc * 32 + 8 * fq;
#pragma unroll
        for (int ai = 0; ai < 2; ++ai)
#pragma unroll
            for (int m = 0; m < 4; ++m) { bf16_t* rowp = Z + (size_t)(row0 + ai * HALF + m * 16) * INCP + col0;
#pragma unroll
                for (int bj = 0; bj < 2; ++bj) st16_wt(rowp + bj * HALF, pack8(acc[ai][bj][m][0], acc[ai][bj][m][1])); }
        if (u.pm < NCTX / BM) {
            if (u.pn >= 4 && u.pn < 12) {
                float* dst = (u.pn < 8 ? sK : sV); const int cb = (u.pn & 3) * BM + wc * 32 + 8 * fq;
#pragma unroll
                for (int ai = 0; ai < 2; ++ai)
#pragma unroll
                    for (int m = 0; m < 4; ++m) { float* rowp = dst + (size_t)(row0 + ai * HALF + m * 16) * 1024 + cb;
#pragma unroll
                        for (int bj = 0; bj < 2; ++bj) { __builtin_nontemporal_store(acc[ai][bj][m][0], (f32x4*)(rowp + bj * HALF)); __builtin_nontemporal_store(acc[ai][bj][m][1], (f32x4*)(rowp + bj * HALF + 4)); } }
            } else if (u.pn == 16 && wc < 2) {
                const int cb = wc * 32 + 8 * fq;
#pragma unroll
                for (int ai = 0; ai < 2; ++ai)
#pragma unroll
                    for (int m = 0; m < 4; ++m) { float* rowp = sKR + (size_t)(row0 + ai * HALF + m * 16) * 64 + cb;
                        __builtin_nontemporal_store(acc[ai][0][m][0], (f32x4*)(rowp)); __builtin_nontemporal_store(acc[ai][0][m][1], (f32x4*)(rowp + 4)); }
            }
        }
    }
};
struct EpiResid {
    static constexpr bool HAS_INIT = false;
    const float* srcA; const float* srcB; float* out; const float* gate;
    __device__ __forceinline__ void operator()(const f32x4 (&acc)[2][2][4][2], const Unit& u, int wr, int wc, int fr, int fq) const {
        const int row0 = u.pm * BM + wr * 64 + fr, col0 = u.pn * BM + wc * 32 + 8 * fq;
        const int v = (u.pm < 32) ? 0 : 1 + ((u.pm - 32) >> 4);
        const float* src = (u.pm < 32) ? srcA : srcB - (size_t)NCTX * DM;
        f32x4 gv[2][2];
#pragma unroll
        for (int bj = 0; bj < 2; ++bj)
#pragma unroll
            for (int n = 0; n < 2; ++n) gv[bj][n] = *(const f32x4*)(gate + (size_t)v * NMOD + col0 + bj * HALF + 4 * n);
#pragma unroll
        for (int ai = 0; ai < 2; ++ai)
#pragma unroll
            for (int m = 0; m < 4; ++m) { const size_t ro = (size_t)(row0 + ai * HALF + m * 16) * DM + col0;
#pragma unroll
                for (int bj = 0; bj < 2; ++bj)
#pragma unroll
                    for (int n = 0; n < 2; ++n) { const f32x4 xs = *(const f32x4*)(src + ro + bj * HALF + 4 * n);
                        *(f32x4*)(out + ro + bj * HALF + 4 * n) = xs * ALPHA + gv[bj][n] * acc[ai][bj][m][n]; } }
    }
};
struct EpiSwiGLU {
    static constexpr bool HAS_INIT = false;
    bf16_t* O;
    __device__ __forceinline__ void operator()(const f32x4 (&acc)[2][2][4][2], const Unit& u, int wr, int wc, int fr, int fq) const {
        const int row0 = u.pm * BM + wr * 64 + fr, col0 = u.pn * HALF + wc * 32 + 8 * fq;
#pragma unroll
        for (int ai = 0; ai < 2; ++ai)
#pragma unroll
            for (int m = 0; m < 4; ++m) { f32x4 f0, f1;
#pragma unroll
                for (int j = 0; j < 4; ++j) { f0[j] = silu_f(acc[ai][0][m][0][j]) * acc[ai][1][m][0][j]; f1[j] = silu_f(acc[ai][0][m][1][j]) * acc[ai][1][m][1][j]; }
                st16_wt(O + (size_t)(row0 + ai * HALF + m * 16) * DFF + col0, pack8(f0, f1)); }
    }
};

struct PanelOrder {
    int c;
    __device__ __forceinline__ bool next(int i, Unit& u) const { u.kind = 0; if (i >= 2) return false; const int xcd = c & 7, off = c >> 3; u.pm = xcd * 8 + i * 4 + (off >> 3); u.pn = off & 7; return true; }
    __device__ __forceinline__ const char* aptr(const Gemm& g, const Unit& u, size_t tstepA) const { return (const char*)g.A + (size_t)u.pm * tstepA; }
    __device__ __forceinline__ const char* bptr(const Gemm& g, const Unit& u, size_t tstepB) const { return (const char*)g.Bt + (size_t)u.pn * tstepB; }
};
template <bool H2, bool SRC_BF, bool OUT_BF> struct EpiResidLN {
    const float* srcA; const float* srcB; const bf16_t* srcH; float* out; bf16_t* outH; const float* gate; const float* lng; const float* lnb; const float* modsh2; bf16_t* Hb;
    float* stats; unsigned* flags; LAS unsigned char* xl;
    __device__ __forceinline__ void ldsrc(const float* src, size_t ro, f32x4& x0, f32x4& x1) const {
        if constexpr (SRC_BF) { const u32x4 w = *(const u32x4*)(srcH + ro); x0 = (f32x4){bflo(w.x), bfhi(w.x), bflo(w.y), bfhi(w.y)}; x1 = (f32x4){bflo(w.z), bfhi(w.z), bflo(w.w), bfhi(w.w)}; }
        else { x0 = *(const f32x4*)(src + ro); x1 = *(const f32x4*)(src + ro + 4); }
    }
    __device__ __forceinline__ void ldsrc_nt(const float* src, size_t ro, f32x4& x0, f32x4& x1) const {
        if constexpr (SRC_BF) { const u32x4 w = __builtin_nontemporal_load((const u32x4*)(srcH + ro)); x0 = (f32x4){bflo(w.x), bfhi(w.x), bflo(w.y), bfhi(w.y)}; x1 = (f32x4){bflo(w.z), bfhi(w.z), bflo(w.w), bfhi(w.w)}; }
        else { x0 = __builtin_nontemporal_load((const f32x4*)(src + ro)); x1 = __builtin_nontemporal_load((const f32x4*)(src + ro + 4)); }
    }
    static constexpr bool HAS_INIT = true;
    __device__ __forceinline__ int init(f32x4 (&acc)[2][2][4][2], const Unit& u, int wr, int wc) const {
        int tid = threadIdx.x; asm volatile("" : "+v"(tid));
        const int lane = tid & 63, fr = tid & 15, fq = (tid >> 4) & 3;
        const int v = (u.pm < 32) ? 0 : 1 + ((u.pm - 32) >> 4);
        const float* gcol = gate + (size_t)v * NMOD + u.pn * BM;
        const f32x4 gc = *(const f32x4*)(gcol + lane * 4);
        const float mn = fminf(fminf(fabsf(gc.x), fabsf(gc.y)), fminf(fabsf(gc.z), fabsf(gc.w)));
        const int slow = __any(!(mn >= 1e-18f)) ? 1 : 0;
        if (slow) {
#pragma unroll
            for (int a = 0; a < 2; ++a)
#pragma unroll
                for (int b = 0; b < 2; ++b)
#pragma unroll
                    for (int m = 0; m < 4; ++m)
#pragma unroll
                        for (int n = 0; n < 2; ++n) acc[a][b][m][n] = (f32x4){0.f, 0.f, 0.f, 0.f};
            return 1;
        }
        const int row0 = u.pm * BM + wr * 64 + fr, col0 = u.pn * BM + wc * 32 + 8 * fq;
        const float* src = (u.pm < 32) ? srcA : srcB - (size_t)NCTX * DM;
        f32x4 gi[2][2];
#pragma unroll
        for (int bj = 0; bj < 2; ++bj)
#pragma unroll
            for (int n = 0; n < 2; ++n) { const f32x4 gvv = *(const f32x4*)(gcol + wc * 32 + 8 * fq + bj * HALF + 4 * n);
                gi[bj][n] = (f32x4){ALPHA / gvv.x, ALPHA / gvv.y, ALPHA / gvv.z, ALPHA / gvv.w}; }
#pragma unroll
        for (int ai = 0; ai < 2; ++ai)
#pragma unroll
            for (int m = 0; m < 4; ++m) { const size_t ro = (size_t)(row0 + ai * HALF + m * 16) * DM + col0;
#pragma unroll
                for (int bj = 0; bj < 2; ++bj) { f32x4 x0, x1; ldsrc_nt(src, ro + bj * HALF, x0, x1);
                    acc[ai][bj][m][0] = x0 * gi[bj][0]; acc[ai][bj][m][1] = x1 * gi[bj][1]; } }
        return 0;
    }
    __device__ __forceinline__ void operator()(const f32x4 (&acc)[2][2][4][2], const Unit& u, int wr, int wc, int fr_, int fq_, int slow) const {
        int tid = threadIdx.x; asm volatile("" : "+v"(tid));
        const int fr = tid & 15, fq = (tid >> 4) & 3;
        const int row0 = u.pm * BM + wr * 64 + fr, col0 = u.pn * BM + wc * 32 + 8 * fq;
        const int v = (u.pm < 32) ? 0 : 1 + ((u.pm - 32) >> 4);
        const float* src = (u.pm < 32) ? srcA : srcB - (size_t)NCTX * DM;
        LAS float* part = (LAS float*)xl;
        LAS float* rowst = (LAS float*)(xl + 8192);
        {
            f32x4 gv[2][2];
#pragma unroll
            for (int bj = 0; bj < 2; ++bj)
#pragma unroll
                for (int n = 0; n < 2; ++n) gv[bj][n] = *(const f32x4*)(gate + (size_t)v * NMOD + col0 + bj * HALF + 4 * n);
#pragma unroll
            for (int ai = 0; ai < 2; ++ai)
#pragma unroll
                for (int m = 0; m < 4; ++m) { const size_t ro = (size_t)(row0 + ai * HALF + m * 16) * DM + col0; float a = 0.f, b = 0.f;
#pragma unroll
                    for (int bj = 0; bj < 2; ++bj) { f32x4 t0 = gv[bj][0] * acc[ai][bj][m][0], t1 = gv[bj][1] * acc[ai][bj][m][1];
                        if (slow) { f32x4 x0, x1; ldsrc(src, ro + bj * HALF, x0, x1); t0 += x0 * ALPHA; t1 += x1 * ALPHA; }
                        a += ((t0.x + t0.y) + (t0.z + t0.w)) + ((t1.x + t1.y) + (t1.z + t1.w));
                        b += ((t0.x * t0.x + t0.y * t0.y) + (t0.z * t0.z + t0.w * t0.w)) + ((t1.x * t1.x + t1.y * t1.y) + (t1.z * t1.z + t1.w * t1.w)); }
                    if (slow && (m == 1 || m == 3)) { asm volatile("" ::: "memory"); __builtin_amdgcn_sched_barrier(0); }
                    a += __shfl_xor(a, 16); b += __shfl_xor(b, 16); a += __shfl_xor(a, 32); b += __shfl_xor(b, 32);
                    if (fq == 0) { const int rl = ai * HALF + wr * 64 + m * 16 + fr; part[(wc * 256 + rl) * 2] = a; part[(wc * 256 + rl) * 2 + 1] = b; } }
        }
        __syncthreads();
        unsigned long long* st = (unsigned long long*)stats + (size_t)(u.pm * 8 + u.pn) * 256;
        if (tid < 256) { float S1 = 0.f, S2 = 0.f;
#pragma unroll
            for (int w = 0; w < 4; ++w) { S1 += part[(w * 256 + tid) * 2]; S2 += part[(w * 256 + tid) * 2 + 1]; }
            const unsigned long long pk = (unsigned long long)__float_as_uint(S1) | ((unsigned long long)__float_as_uint(S2) << 32);
            __hip_atomic_store(st + tid, pk, __ATOMIC_RELAXED, __HIP_MEMORY_SCOPE_AGENT); }
        asm volatile("s_waitcnt vmcnt(0)" ::: "memory");
        __syncthreads();
        if (tid == 0) {
            __hip_atomic_fetch_add(flags + u.pm, 1u, __ATOMIC_RELAXED, __HIP_MEMORY_SCOPE_AGENT);
            unsigned sp = 0;
            while (__hip_atomic_load(flags + u.pm, __ATOMIC_RELAXED, __HIP_MEMORY_SCOPE_AGENT) < 8u) { __builtin_amdgcn_s_sleep(1); if (++sp > (1u << 22)) break; }
        }
        __syncthreads();
        if (tid < 256) { float S1 = 0.f, S2 = 0.f; const unsigned long long* sp0 = (const unsigned long long*)stats + (size_t)(u.pm * 8) * 256 + tid;
#pragma unroll
            for (int t = 0; t < 8; ++t) { const unsigned long long pk = __hip_atomic_load(sp0 + t * 256, __ATOMIC_RELAXED, __HIP_MEMORY_SCOPE_AGENT);
                S1 += __uint_as_float((unsigned)pk); S2 += __uint_as_float((unsigned)(pk >> 32)); }
            const float mean = S1 * (1.f / DM), var = fmaxf(S2 * (1.f / DM) - mean * mean, 0.f);
            rowst[tid * 2] = mean; rowst[tid * 2 + 1] = rsqrtf(var + LN_EPS); }
        __syncthreads();
        const float* sh2 = modsh2 + (size_t)v * NMOD; const float* sc2 = sh2 + DM;
        int col0b = col0; asm volatile("" : "+v"(col0b));
#pragma unroll
        for (int bj = 0; bj < 2; ++bj) { const int c = col0b + bj * HALF;
            const f32x4 g0 = *(const f32x4*)(lng + c), g1 = *(const f32x4*)(lng + c + 4), b0 = *(const f32x4*)(lnb + c), b1 = *(const f32x4*)(lnb + c + 4);
            const f32x4 gt0 = *(const f32x4*)(gate + (size_t)v * NMOD + c), gt1 = *(const f32x4*)(gate + (size_t)v * NMOD + c + 4);
            f32x4 s0, s1, h0, h1;
            if constexpr (H2) { s0 = *(const f32x4*)(sc2 + c) + 1.f; s1 = *(const f32x4*)(sc2 + c + 4) + 1.f; h0 = *(const f32x4*)(sh2 + c); h1 = *(const f32x4*)(sh2 + c + 4); }
#pragma unroll
            for (int ai = 0; ai < 2; ++ai) {
#pragma unroll
                for (int m = 0; m < 4; ++m) { const int rl = ai * HALF + wr * 64 + m * 16 + fr; const float mean = rowst[rl * 2], rstd = rowst[rl * 2 + 1];
                    const size_t ro = (size_t)(u.pm * BM + rl) * DM + c;
                    f32x4 t0 = gt0 * acc[ai][bj][m][0], t1 = gt1 * acc[ai][bj][m][1];
                    if (slow) { f32x4 x0, x1; ldsrc_nt(src, ro, x0, x1); t0 += x0 * ALPHA; t1 += x1 * ALPHA; }
                    const f32x4 y0 = (t0 - mean) * rstd * g0 + b0, y1 = (t1 - mean) * rstd * g1 + b1;
                    if constexpr (OUT_BF) st16_wt(outH + ro, pack8(y0, y1));
                    else { __builtin_nontemporal_store(y0, (f32x4*)(out + ro)); __builtin_nontemporal_store(y1, (f32x4*)(out + ro + 4)); }
                    if constexpr (H2) st16_wt(Hb + ro, pack8(y0 * s0 + h0, y1 * s1 + h1)); }
                if (slow) { asm volatile("" ::: "memory"); __builtin_amdgcn_sched_barrier(0); } } }
        __syncthreads();
    }
};
}

namespace att {
constexpr int QBLK = 32, KVBLK = 64;
constexpr int SHM_V = KVBLK * 128 * 2, SHM_K = KVBLK * 128 * 2, SHM_KR = KVBLK * 64 * 2;
constexpr int L_V = 0, L_K = 2 * SHM_V, L_KR = L_K + 2 * SHM_K, L_WS = L_KR + 2 * SHM_KR, L_RPB = L_WS + NWAVES * 64 * 4, L_QR = L_RPB + 2048, L_END = L_QR + NWAVES * 4096;
static_assert(L_END <= 131072, "attention LDS");
constexpr float THR = 8.f;
constexpr float NEG = -3.0e38f;
#ifndef ATT_SDEPTH
#define ATT_SDEPTH 1
#endif
constexpr int SDEPTH = ATT_SDEPTH;
#define KSWZ(row, colB) ((row) * 256 + ((colB) ^ (((row) & 7) << 4)))
#define KRSWZ(row, colB) ((row) * 128 + ((colB) ^ (((row) & 7) << 4)))
#define SBAR() __builtin_amdgcn_sched_barrier(0)
__device__ __forceinline__ int crow(int r, int hi) { return (r & 3) + 8 * (r >> 2) + 4 * hi; }
template <int DK> struct Cst { static constexpr float SCALE = (DK == 128) ? 0.08838834764831845f : 0.07216878364870323f; };

template <int DK>
__device__ __forceinline__ void partialSM(f32x16& p0, f32x16& p1, float& m_reg, float& mn, float& alpha) {
    constexpr float SCALE = Cst<DK>::SCALE, C = SCALE * 1.4426950408889634f;
    float pmax = p0[0];
#pragma unroll
    for (int r = 1; r < 16; ++r) pmax = fmaxf(pmax, p0[r]);
#pragma unroll
    for (int r = 0; r < 16; ++r) pmax = fmaxf(pmax, p1[r]);
    { auto rr = __builtin_amdgcn_permlane32_swap(__float_as_uint(pmax), __float_as_uint(pmax), false, false);
      pmax = fmaxf(__uint_as_float(rr[0]), __uint_as_float(rr[1])); }
    if (__builtin_expect(__all(pmax - m_reg <= THR / SCALE), 1)) { mn = m_reg; alpha = 1.f; }
    else { mn = fmaxf(m_reg, pmax); alpha = __builtin_amdgcn_exp2f((m_reg - mn) * C); m_reg = mn; }
    const float mnC = -mn * C;
#pragma unroll
    for (int r = 0; r < 16; ++r) p0[r] = fmaf(p0[r], C, mnC);
#pragma unroll
    for (int r = 0; r < 16; ++r) p1[r] = fmaf(p1[r], C, mnC);
#pragma unroll
    for (int r = 0; r < 16; ++r) p0[r] = __builtin_amdgcn_exp2f(p0[r]);
}
__device__ __forceinline__ void finishSM(f32x16& p0, f32x16& p1, float alpha, float& l_reg, bf16x8& pa0, bf16x8& pa1, bf16x8& pa2, bf16x8& pa3) {
#pragma unroll
    for (int r = 0; r < 16; ++r) p1[r] = __builtin_amdgcn_exp2f(p1[r]);
    float ps = 0;
#pragma unroll
    for (int r = 0; r < 16; ++r) ps += p0[r];
#pragma unroll
    for (int r = 0; r < 16; ++r) ps += p1[r];
    { auto rr = __builtin_amdgcn_permlane32_swap(__float_as_uint(ps), __float_as_uint(ps), false, false);
      ps = __uint_as_float(rr[0]) + __uint_as_float(rr[1]); }
    l_reg = l_reg * alpha + ps;
#define PK4(P, BASE, OUT) do { unsigned a0 = cvtpk(P[BASE + 0], P[BASE + 1]), a1 = cvtpk(P[BASE + 2], P[BASE + 3]);   \
    unsigned b0 = cvtpk(P[BASE + 4], P[BASE + 5]), b1 = cvtpk(P[BASE + 6], P[BASE + 7]);                              \
    auto r0 = __builtin_amdgcn_permlane32_swap(a0, b0, false, false); auto r1 = __builtin_amdgcn_permlane32_swap(a1, b1, false, false); \
    u32x4 w = {r0[0], r1[0], r0[1], r1[1]}; OUT = *reinterpret_cast<bf16x8*>(&w); } while (0)
    PK4(p0, 0, pa0); PK4(p0, 8, pa1); PK4(p1, 0, pa2); PK4(p1, 8, pa3);
#undef PK4
}
template <int DK>
__device__ __forceinline__ void qkt(f32x16& p0, f32x16& p1, const char* Ks, const char* Krs, const bf16x8* qr, const char* Qrl, int r32, int hi) {
    p0 = f32x16{}; p1 = f32x16{};
#pragma unroll
    for (int d0 = 0; d0 < 8; ++d0) { const int cb = (d0 * 16 + hi * 8) * 2;
        bf16x8 b0 = *reinterpret_cast<const bf16x8*>(Ks + KSWZ(r32, cb));
        bf16x8 b1 = *reinterpret_cast<const bf16x8*>(Ks + KSWZ(32 + r32, cb));
        p0 = __builtin_amdgcn_mfma_f32_32x32x16_bf16(b0, qr[d0], p0, 0, 0, 0);
        p1 = __builtin_amdgcn_mfma_f32_32x32x16_bf16(b1, qr[d0], p1, 0, 0, 0); }
    if constexpr (DK == 192) {
#pragma unroll
        for (int d0 = 0; d0 < 4; ++d0) { const int cb = (d0 * 16 + hi * 8) * 2;
            bf16x8 b0 = *reinterpret_cast<const bf16x8*>(Krs + KRSWZ(r32, cb));
            bf16x8 b1 = *reinterpret_cast<const bf16x8*>(Krs + KRSWZ(32 + r32, cb));
            const bf16x8 qd = *reinterpret_cast<const bf16x8*>(Qrl + d0 * 1024);
            p0 = __builtin_amdgcn_mfma_f32_32x32x16_bf16(b0, qd, p0, 0, 0, 0);
            p1 = __builtin_amdgcn_mfma_f32_32x32x16_bf16(b1, qd, p1, 0, 0, 0); }
    }
}
__device__ __forceinline__ int v_st(int k, int c) { const int kk = (k & ~0xC) | ((k & 4) << 1) | ((k & 8) >> 1); return ((kk >> 3) * 4 + (c >> 5)) * 512 + ((kk & 7) * 32 + (c & 31)) * 2; }
__device__ __forceinline__ int v_rd_base(int lane) { return ((lane & 3) << 3) | (((lane >> 2) & 3) << 6) | (((lane >> 4) & 1) << 5) | (((lane >> 5) & 1) << 8); }
constexpr int v_rd_off(int d0, int ks, int half) { return d0 * 512 + ks * 4096 + half * 2048; }
template <int OFF> __device__ __forceinline__ s16x4 tr_read(int vb) {
    s16x4 r; asm volatile("ds_read_b64_tr_b16 %0, %1 offset:%2" : "=&v"(r) : "v"(vb), "i"(OFF) : "memory"); return r;
}
template <int D0> __device__ __forceinline__ void pv_one(f32x16& od, int vb, bf16x8 pa0, bf16x8 pa1, bf16x8 pa2, bf16x8 pa3) {
    const s16x4 l0 = tr_read<v_rd_off(D0, 0, 0)>(vb), h0 = tr_read<v_rd_off(D0, 0, 1)>(vb), l1 = tr_read<v_rd_off(D0, 1, 0)>(vb), h1 = tr_read<v_rd_off(D0, 1, 1)>(vb);
    const s16x4 l2 = tr_read<v_rd_off(D0, 2, 0)>(vb), h2 = tr_read<v_rd_off(D0, 2, 1)>(vb), l3 = tr_read<v_rd_off(D0, 3, 0)>(vb), h3 = tr_read<v_rd_off(D0, 3, 1)>(vb);
    asm volatile("s_waitcnt lgkmcnt(0)" ::: "memory"); SBAR();
#define PK(L, H) (bf16x8){L[0], L[1], L[2], L[3], H[0], H[1], H[2], H[3]}
    od = __builtin_amdgcn_mfma_f32_32x32x16_bf16(pa0, PK(l0, h0), od, 0, 0, 0);
    od = __builtin_amdgcn_mfma_f32_32x32x16_bf16(pa1, PK(l1, h1), od, 0, 0, 0);
    od = __builtin_amdgcn_mfma_f32_32x32x16_bf16(pa2, PK(l2, h2), od, 0, 0, 0);
    od = __builtin_amdgcn_mfma_f32_32x32x16_bf16(pa3, PK(l3, h3), od, 0, 0, 0);
#undef PK
}
__device__ __forceinline__ void pv_d0(f32x16* o, int vb, bf16x8 pa0, bf16x8 pa1, bf16x8 pa2, bf16x8 pa3) {
    pv_one<0>(o[0], vb, pa0, pa1, pa2, pa3); pv_one<1>(o[1], vb, pa0, pa1, pa2, pa3); pv_one<2>(o[2], vb, pa0, pa1, pa2, pa3); pv_one<3>(o[3], vb, pa0, pa1, pa2, pa3);
}
__device__ __forceinline__ void na_mask(f32x16& p0, f32x16& p1, bool rowok, const float* tab, int cs, int hi) {
    if (!rowok) {
#pragma unroll
        for (int r = 0; r < 16; ++r) { p0[r] = NEG; p1[r] = NEG; }
    } else {
#pragma unroll
        for (int r = 0; r < 16; ++r) { const int kc = crow(r, hi);
            const bool ok0 = (unsigned)(kc - cs) < 16u, ok1 = (unsigned)(kc + 32 - cs) < 16u;
            const float b0 = tab[ok0 ? kc : cs], b1 = tab[ok1 ? kc + 32 : cs];
            p0[r] = ok0 ? p0[r] + b0 : NEG; p1[r] = ok1 ? p1[r] + b1 : NEG; }
    }
}

struct Seg { const bf16_t* K; const bf16_t* V; const bf16_t* KR; int ldk, ldkr; };

template <int DK, bool LAT, bool SIMPLE>
__device__ __forceinline__ void attn_unit(const bf16_t* __restrict__ Qb, int ldq, const Seg s0, int NT0, const Seg s1, int NT, bf16_t* __restrict__ Ob, char* lds,
                                          int qpos0, int kr0, const float* __restrict__ rpb_h) {
    constexpr int NLD = (DK == 192) ? 5 : 4;
    int tid = threadIdx.x; asm volatile("" : "+v"(tid));
    const int wid = __builtin_amdgcn_readfirstlane(tid >> 6), lane = tid & 63, r32 = lane & 31, hi = lane >> 5;
    char* V_lds = lds + L_V; char* K_lds = lds + L_K; char* KR_lds = lds + L_KR;
    float* ws = (float*)(lds + L_WS) + wid * 64; float* li_l = ws; float* al_l = ws + 32;
    float* rpbL = (float*)(lds + L_RPB);
    __syncthreads();
    if (wid >= 4) __builtin_amdgcn_s_setprio(1);
    if constexpr (LAT && DK == 128) { if (tid < 465) rpbL[tid] = rpb_h[tid] * (1.f / Cst<128>::SCALE); }
    float m_reg = -1e30f, l_reg = 0; f32x16 o[4] = {}; bf16x8 qr[8];
    char* Qrl = lds + L_QR + wid * 4096 + lane * 16;
    const bf16_t* Qw = Qb + (size_t)(wid * QBLK + r32) * ldq + hi * 8;
#pragma unroll
    for (int d0 = 0; d0 < 8; ++d0) qr[d0] = *reinterpret_cast<const bf16x8*>(Qw + d0 * 16);
    if constexpr (DK == 192) {
        bf16x8 q8 = *reinterpret_cast<const bf16x8*>(Qw + 128), q9 = *reinterpret_cast<const bf16x8*>(Qw + 144), q10 = *reinterpret_cast<const bf16x8*>(Qw + 160), q11 = *reinterpret_cast<const bf16x8*>(Qw + 176);
        if constexpr (LAT) {
        const int n = qpos0 + wid * QBLK + r32; const float grow = (float)(n >> 6), gcol = (float)(n & 63);
#pragma unroll
        for (int e = 0; e < 8; ++e) { const float invf = exp2f(-(float)(hi * 8 + e) * (13.287712379549449f / 16.f));
            { const float a = grow * invf, c = __cosf(a), s = __sinf(a), x1 = bf2f(q8[e]), x2 = bf2f(q9[e]); q8[e] = f2bf(x1 * c - x2 * s); q9[e] = f2bf(x2 * c + x1 * s); }
            { const float a = gcol * invf, c = __cosf(a), s = __sinf(a), x1 = bf2f(q10[e]), x2 = bf2f(q11[e]); q10[e] = f2bf(x1 * c - x2 * s); q11[e] = f2bf(x2 * c + x1 * s); } }
        }
        *(bf16x8*)(Qrl) = q8; *(bf16x8*)(Qrl + 1024) = q9; *(bf16x8*)(Qrl + 2048) = q10; *(bf16x8*)(Qrl + 3072) = q11;
    }
    const int qrow = (qpos0 >> 6) + (wid >> 1), qcol = (wid & 1) * 32 + r32;
    const int rs = min(max(qrow - 4, 0), 56), cs = min(max(qcol - 8, 0), 48);
    const int sr = tid >> 4, sc = (tid & 15) * 8, vst0 = v_st(sr, sc), vst1 = v_st(32 + sr, sc);
    const int krr = tid >> 3, krc = (tid & 7) * 8;
    const int vb0 = (int)(uintptr_t)V_lds + v_rd_base(lane);
    struct { bf16x8 vs0, vs1, ks0, ks1, kr; } sr_[SDEPTH];
#define TLOAD(i, j) do { const int _j = (j); const bool _a = !(LAT && DK == 128) || _j < NT0; const int _jj = _a ? _j : _j - NT0; const int _ld = _a ? s0.ldk : s1.ldk; \
    const bf16_t* _K = (_a ? s0.K : s1.K) + (size_t)_jj * KVBLK * _ld; const bf16_t* _V = (_a ? s0.V : s1.V) + (size_t)_jj * KVBLK * _ld; \
    sr_[i].vs0 = *reinterpret_cast<const bf16x8*>(_V + (size_t)sr * _ld + sc); sr_[i].vs1 = *reinterpret_cast<const bf16x8*>(_V + (size_t)(32 + sr) * _ld + sc); \
    sr_[i].ks0 = *reinterpret_cast<const bf16x8*>(_K + (size_t)sr * _ld + sc); sr_[i].ks1 = *reinterpret_cast<const bf16x8*>(_K + (size_t)(32 + sr) * _ld + sc); \
    if constexpr (DK == 192) { const int _lr = _a ? s0.ldkr : s1.ldkr; const bf16_t* _R = (_a ? s0.KR : s1.KR) + (size_t)_jj * KVBLK * _lr; \
        sr_[i].kr = *reinterpret_cast<const bf16x8*>(_R + (size_t)krr * _lr + krc); } } while (0)
#define TWRITE(b, i) do { *(bf16x8*)(V_lds + (b) * SHM_V + vst0) = sr_[i].vs0; *(bf16x8*)(V_lds + (b) * SHM_V + vst1) = sr_[i].vs1; const int kc = sc * 2; \
    *(bf16x8*)(K_lds + (b) * SHM_K + KSWZ(sr, kc)) = sr_[i].ks0; *(bf16x8*)(K_lds + (b) * SHM_K + KSWZ(32 + sr, kc)) = sr_[i].ks1; \
    if constexpr (DK == 192) { *(bf16x8*)(KR_lds + (b) * SHM_KR + KRSWZ(krr, krc * 2)) = sr_[i].kr; } } while (0)
#define SWAIT() do { if constexpr (SDEPTH == 2) { if constexpr (NLD == 5) asm volatile("s_waitcnt vmcnt(5)" ::: "memory"); else asm volatile("s_waitcnt vmcnt(4)" ::: "memory"); } \
    else asm volatile("s_waitcnt vmcnt(0)" ::: "memory"); } while (0)
#define RESC(a) do { if (__any((a) < 1.f)) { if (hi == 0) al_l[r32] = (a); asm volatile("s_waitcnt lgkmcnt(0)" ::: "memory"); \
    _Pragma("unroll") for (int d = 0; d < 4; ++d) _Pragma("unroll") for (int r = 0; r < 16; ++r) o[d][r] *= al_l[crow(r, hi)]; } } while (0)
#define MASK(P0, P1, j) do { if constexpr (LAT && DK == 128) { const int _j = (j); if (_j < NT0) { const int krow = kr0 + _j; \
    const bool rowok = (krow >= rs) && (krow < rs + 8); const int dr = min(max(krow - qrow + 7, 0), 14); na_mask(P0, P1, rowok, rpbL + dr * 31 + 15 - qcol, cs, hi); } } } while (0)
    f32x16 pA0, pA1, pB0, pB1; float mnA, mnB, alA, alB; bf16x8 pa0, pa1, pa2, pa3;
    if constexpr (SIMPLE) {
        TLOAD(0, 0); asm volatile("s_waitcnt vmcnt(0)" ::: "memory"); TWRITE(0, 0); __syncthreads();
        for (int j = 0; j < NT; ++j) {
            const int bb = j & 1;
            if (j + 1 < NT) TLOAD(0, j + 1);
            bool active = true;
            if constexpr (LAT && DK == 128) { if (j < NT0) { const int krow = kr0 + j; active = (krow >= rs) && (krow < rs + 8); } }
            if (active) {
            SBAR(); qkt<DK>(pA0, pA1, K_lds + bb * SHM_K, KR_lds + bb * SHM_KR, qr, Qrl, r32, hi); MASK(pA0, pA1, j); partialSM<DK>(pA0, pA1, m_reg, mnA, alA);
            RESC(alA); finishSM(pA0, pA1, alA, l_reg, pa0, pa1, pa2, pa3); SBAR();
            pv_d0(o, vb0 + bb * SHM_V, pa0, pa1, pa2, pa3);
            }
            if (j + 1 < NT) { if (bb) TWRITE(0, 0); else TWRITE(1, 0); }
            __syncthreads();
        }
    } else {
    constexpr int SE = 0, SO = SDEPTH - 1;
    TLOAD(SE, 0); asm volatile("s_waitcnt vmcnt(0)" ::: "memory"); TWRITE(0, SE); __syncthreads();
    qkt<DK>(pA0, pA1, K_lds, KR_lds, qr, Qrl, r32, hi); MASK(pA0, pA1, 0); partialSM<DK>(pA0, pA1, m_reg, mnA, alA);
    TLOAD(SO, 1); if constexpr (SDEPTH == 2) { if (2 < NT) TLOAD(SE, 2); }
    SWAIT(); TWRITE(1, SO); __syncthreads();
    for (int j = 1; j + 1 < NT; j += 2) {
        SBAR(); qkt<DK>(pB0, pB1, K_lds + SHM_K, KR_lds + SHM_KR, qr, Qrl, r32, hi);
        finishSM(pA0, pA1, alA, l_reg, pa0, pa1, pa2, pa3); SBAR();
        TLOAD(SO, j + SDEPTH); SBAR();
        pv_d0(o, vb0, pa0, pa1, pa2, pa3); MASK(pB0, pB1, j); partialSM<DK>(pB0, pB1, m_reg, mnB, alB);
        __syncthreads(); SWAIT(); TWRITE(0, SE);
        RESC(alB); __syncthreads();
        SBAR(); qkt<DK>(pA0, pA1, K_lds, KR_lds, qr, Qrl, r32, hi);
        finishSM(pB0, pB1, alB, l_reg, pa0, pa1, pa2, pa3); SBAR();
        if (SDEPTH == 1 || j + 3 < NT) TLOAD(SE, j + 1 + SDEPTH); SBAR();
        pv_d0(o, vb0 + SHM_V, pa0, pa1, pa2, pa3); MASK(pA0, pA1, j + 1); partialSM<DK>(pA0, pA1, m_reg, mnA, alA);
        __syncthreads(); SWAIT(); TWRITE(1, SO);
        RESC(alA); __syncthreads();
    }
    SBAR(); qkt<DK>(pB0, pB1, K_lds + SHM_K, KR_lds + SHM_KR, qr, Qrl, r32, hi);
    finishSM(pA0, pA1, alA, l_reg, pa0, pa1, pa2, pa3); SBAR();
    pv_d0(o, vb0, pa0, pa1, pa2, pa3); MASK(pB0, pB1, NT - 1); partialSM<DK>(pB0, pB1, m_reg, mnB, alB);
    __syncthreads(); RESC(alB);
    finishSM(pB0, pB1, alB, l_reg, pa0, pa1, pa2, pa3); SBAR();
    pv_d0(o, vb0 + SHM_V, pa0, pa1, pa2, pa3);
    }
    if (hi == 0) li_l[r32] = l_reg; asm volatile("s_waitcnt lgkmcnt(0)" ::: "memory");
    float rli[16];
#pragma unroll
    for (int r = 0; r < 16; ++r) rli[r] = __builtin_amdgcn_rcpf(li_l[crow(r, hi)]);
    bf16_t* Ow = Ob + (size_t)(wid * QBLK) * DM;
#pragma unroll
    for (int r = 0; r < 16; ++r) { const int orow = crow(r, hi);
#pragma unroll
        for (int d0 = 0; d0 < 4; ++d0) Ow[(size_t)orow * DM + d0 * 32 + r32] = (bf16_t)f2bf(o[d0][r] * rli[r]); }
    __builtin_amdgcn_s_setprio(0);
#undef TLOAD
#undef TWRITE
#undef SWAIT
#undef RESC
#undef MASK
}
}

struct Params { const float* in[23]; float* out; unsigned char* ws; int ph_lo, ph_hi, never, pad; };
enum { I_XP = 0, I_XS, I_CNK, I_CNV, I_CCKV, I_CKR, I_C, I_CCTX, I_WMOD, I_BMOD, I_WIN, I_QAN, I_KVAN, I_WQB, I_WKVB, I_RPB, I_WO, I_LN1G, I_LN1B, I_WGU, I_WDOWN, I_LN2G, I_LN2B };

__device__ __forceinline__ void transpose_item(const float* __restrict__ W, int K, int N, bf16_t* __restrict__ WT, int k0, int n0, int rowbase, LAS float* scr, int lane) {
    float tv[32];
#pragma unroll
    for (int i = 0; i < 32; ++i) tv[i] = __builtin_nontemporal_load(W + (size_t)(k0 + 2 * i + (lane >> 5)) * N + n0 + (lane & 31));
#pragma unroll
    for (int i = 0; i < 32; ++i) scr[(2 * i + (lane >> 5)) * 33 + (lane & 31)] = tv[i];
    LDS_WAIT(); asm volatile("" ::: "memory");
    const int c = lane & 7;
#pragma unroll
    for (int j = 0; j < 4; ++j) { const int n = (lane >> 3) + 8 * j; const LAS float* s = scr + (8 * c) * 33 + n;
        u32x4 o; o.x = cvtpk(s[0 * 33], s[1 * 33]); o.y = cvtpk(s[2 * 33], s[3 * 33]); o.z = cvtpk(s[4 * 33], s[5 * 33]); o.w = cvtpk(s[6 * 33], s[7 * 33]);
        *(u32x4*)(WT + (size_t)(rowbase + n) * K + k0 + 8 * c) = o; }
    LDS_WAIT(); asm volatile("" ::: "memory");
}
__device__ __forceinline__ void transpose_plain(const float* W, int K, int N, bf16_t* WT, int item, LAS float* scr, int lane) {
    const int nblk = N / 32, kb = item / nblk, nb = item % nblk; transpose_item(W, K, N, WT, 64 * kb, 32 * nb, 32 * nb, scr, lane);
}
__device__ __forceinline__ void cvt_copy(const float* __restrict__ src, bf16_t* __restrict__ dst, long n8, long gt, long ngt) {
    for (long i = gt; i < n8; i += ngt) { const f32x4 a = __builtin_nontemporal_load((const f32x4*)(src + i * 8)), b = __builtin_nontemporal_load((const f32x4*)(src + i * 8 + 4)); *(u32x4*)(dst + i * 8) = pg8::pack8(a, b); }
}

__device__ __forceinline__ void phase0(const Params& p, unsigned char* lds) {
    const int tid = threadIdx.x, lane = tid & 63, wave = tid >> 6, G = gridDim.x;
    float* mod = (float*)(p.ws + OFF_MOD);
    float* red = (float*)lds;
    for (int it = blockIdx.x; it < (NMOD / 64) * 4; it += G) {
        const int cg = it >> 2, kq = it & 3, n0 = cg * 64, k0 = kq * 512 + wave * 64; const float* W = p.in[I_WMOD] + (size_t)k0 * NMOD + n0 + lane;
        const float s0 = silu_f(p.in[I_CCTX][k0 + lane]), s1 = silu_f(p.in[I_C][k0 + lane]), s2 = silu_f(p.in[I_C][DM + k0 + lane]);
        float a0 = 0.f, a1 = 0.f, a2 = 0.f;
#pragma unroll 16
        for (int kk = 0; kk < 64; ++kk) { const float w = __builtin_nontemporal_load(W + (size_t)kk * NMOD);
            a0 = fmaf(__uint_as_float(__builtin_amdgcn_readlane(__float_as_uint(s0), kk)), w, a0);
            a1 = fmaf(__uint_as_float(__builtin_amdgcn_readlane(__float_as_uint(s1), kk)), w, a1);
            a2 = fmaf(__uint_as_float(__builtin_amdgcn_readlane(__float_as_uint(s2), kk)), w, a2); }
        __syncthreads();
        red[(wave * 3 + 0) * 64 + lane] = a0; red[(wave * 3 + 1) * 64 + lane] = a1; red[(wave * 3 + 2) * 64 + lane] = a2;
        __syncthreads();
        if (tid < 192) { const int v = tid >> 6; float s = (kq == 0) ? p.in[I_BMOD][n0 + lane] : 0.f;
#pragma unroll
            for (int w = 0; w < 8; ++w) s += red[(w * 3 + v) * 64 + lane];
            atomicAdd(mod + (size_t)v * NMOD + n0 + lane, s); }
    }
}
__device__ __forceinline__ void phase1_weights(const Params& p, unsigned char* lds) {
    const int tid = threadIdx.x, lane = tid & 63, wave = tid >> 6, G = gridDim.x;
    unsigned char* ws = p.ws;
    LAS float* scr = (LAS float*)((LAS unsigned char*)lds + wave * 16384);
    const int gw = blockIdx.x * NWAVES + wave, NGW = G * NWAVES;
    constexpr int IT_IN = (DM / 64) * (INC / 32);
    for (int it = gw; it < IT_IN; it += NGW) transpose_plain(p.in[I_WIN], DM, INC, (bf16_t*)(ws + OFF_WIN), it, scr, lane);
    const long gt = (long)blockIdx.x * NTHREADS + tid, ngt = (long)G * NTHREADS;
    { u32x4* z = (u32x4*)((bf16_t*)(ws + OFF_WIN) + (size_t)INC * DM); const long nz = (long)(INCP - INC) * DM / 8;
      for (long i = gt; i < nz; i += ngt) z[i] = (u32x4){0u, 0u, 0u, 0u}; }
    cvt_copy(p.in[I_CNK], (bf16_t*)(ws + OFF_CNK), 1024L * 1024 / 8, gt, ngt);
    cvt_copy(p.in[I_CNV], (bf16_t*)(ws + OFF_CNV), 1024L * 1024 / 8, gt, ngt);
    cvt_copy(p.in[I_CKR], (bf16_t*)(ws + OFF_KRL) + (size_t)4096 * 64, 512L * 64 / 8, gt, ngt);
    cvt_copy(p.in[I_CKR] + 512 * 64, (bf16_t*)(ws + OFF_KRL) + (size_t)(4608 + 4096) * 64, 512L * 64 / 8, gt, ngt);
}

__device__ __forceinline__ void phase1(const Params& p) {
    const int tid = threadIdx.x, lane = tid & 63, wave = tid >> 6;
    const int gw = blockIdx.x * NWAVES + wave, NGW = gridDim.x * NWAVES;
    const float* mod = (const float*)(p.ws + OFF_MOD); bf16_t* H = (bf16_t*)(p.ws + OFF_R1);
    for (int ch = gw; ch < MTOK / 8; ch += NGW) {
        const int m0 = ch * 8; const int v = (m0 < NCTX) ? 0 : 1 + ((m0 - NCTX) >> 12);
        const float* sh = mod + (size_t)v * NMOD; const float* sc = sh + DM;
        const float* x = (m0 < NCTX) ? p.in[I_XP] + (size_t)m0 * DM : p.in[I_XS] + (size_t)(m0 - NCTX) * DM;
        f32x4 s[8], h[8];
#pragma unroll
        for (int j = 0; j < 8; ++j) { s[j] = *(const f32x4*)(sc + j * 256 + lane * 4) + 1.f; h[j] = *(const f32x4*)(sh + j * 256 + lane * 4); }
#pragma unroll 1
        for (int r = 0; r < 8; r += 4) {
            f32x4 a[4][8];
#pragma unroll
            for (int q = 0; q < 4; ++q)
#pragma unroll
                for (int j = 0; j < 8; ++j) a[q][j] = __builtin_nontemporal_load((const f32x4*)(x + (size_t)(r + q) * DM + j * 256 + lane * 4));
#pragma unroll
            for (int q = 0; q < 4; ++q)
#pragma unroll
                for (int j = 0; j < 8; ++j) { const f32x4 ya = a[q][j] * s[j] + h[j];
                    u32x2 wa; wa.x = cvtpk(ya.x, ya.y); wa.y = cvtpk(ya.z, ya.w);
                    st8_wt(H + (size_t)(m0 + r + q) * DM + j * 256 + lane * 4, wa); }
        }
    }
}

__device__ __forceinline__ void phase3(const Params& p) {
    const int tid = threadIdx.x, lane = tid & 63, wave = tid >> 6;
    const int gw = blockIdx.x * NWAVES + wave, NGW = gridDim.x * NWAVES;
    bf16_t* Z = (bf16_t*)(p.ws + OFF_Z); bf16_t* KRL = (bf16_t*)(p.ws + OFF_KRL);
    float* sCKV = p.out + (size_t)MTOK * DM + (size_t)2 * NCTX * 1024;
    f32x4 gq0 = *(const f32x4*)(p.in[I_QAN] + lane * 8), gq1 = *(const f32x4*)(p.in[I_QAN] + lane * 8 + 4);
    f32x4 gk0 = *(const f32x4*)(p.in[I_KVAN] + lane * 8), gk1 = *(const f32x4*)(p.in[I_KVAN] + lane * 8 + 4);
    const float invf = exp2f(-(float)(lane & 15) * (13.287712379549449f / 16.f));
    {   bf16_t* CS = (bf16_t*)(p.ws + OFF_CCKVS); const float* src = p.in[I_CCKV];
        for (long i = (long)blockIdx.x * NTHREADS + tid; i < 1024L * 64; i += (long)gridDim.x * NTHREADS) { const long r = i >> 6, c8 = (i & 63) * 8;
            const f32x4 a = __builtin_nontemporal_load((const f32x4*)(src + r * 512 + c8)), b = __builtin_nontemporal_load((const f32x4*)(src + r * 512 + c8 + 4));
            *(u32x4*)(CS + r * INCP + c8) = pg8::pack8(a, b); } }
    constexpr int R = 4;
    for (int m0 = gw; m0 < MTOK; m0 += R * NGW) {
        u32x4 wq[R], wk[R]; float xr[R];
#pragma unroll
        for (int r = 0; r < R; ++r) { const int m = m0 + r * NGW; bf16_t* z = Z + (size_t)m * INCP;
            wq[r] = *(const u32x4*)(z + ZQL + lane * 8); wk[r] = *(const u32x4*)(z + ZKVL + lane * 8); xr[r] = bf2f((short)z[ZKR + lane]); }
#pragma unroll
        for (int r = 0; r < R; ++r) { const int m = m0 + r * NGW; bf16_t* z = Z + (size_t)m * INCP;
            {   const u32x4 w = wq[r];
                f32x4 a = {bflo(w.x), bfhi(w.x), bflo(w.y), bfhi(w.y)}, b = {bflo(w.z), bfhi(w.z), bflo(w.w), bfhi(w.w)};
                float ss = a.x * a.x + a.y * a.y + a.z * a.z + a.w * a.w + b.x * b.x + b.y * b.y + b.z * b.z + b.w * b.w;
                const float rs = rsqrtf(wave_sum(ss) * (1.f / 512.f) + RMS_EPS);
                *(u32x4*)(z + ZQL + lane * 8) = pg8::pack8(a * rs * gq0, b * rs * gq1); }
            {   const u32x4 w = wk[r];
                f32x4 a = {bflo(w.x), bfhi(w.x), bflo(w.y), bfhi(w.y)}, b = {bflo(w.z), bfhi(w.z), bflo(w.w), bfhi(w.w)};
                float ss = a.x * a.x + a.y * a.y + a.z * a.z + a.w * a.w + b.x * b.x + b.y * b.y + b.z * b.z + b.w * b.w;
                const float rs = rsqrtf(wave_sum(ss) * (1.f / 512.f) + RMS_EPS);
                a = a * rs * gk0; b = b * rs * gk1;
                *(u32x4*)(z + ZKVL + lane * 8) = pg8::pack8(a, b);
                if (m < NCTX) { __builtin_nontemporal_store(a, (f32x4*)(sCKV + (size_t)m * 512 + lane * 8)); __builtin_nontemporal_store(b, (f32x4*)(sCKV + (size_t)m * 512 + lane * 8 + 4)); } }
            if (m >= NCTX) {
                const int n = (m - NCTX) & 4095; const float pos = (lane < 32) ? (float)(n >> 6) : (float)(n & 63);
                const float x = xr[r]; const float xp = __shfl_xor(x, 16);
                const float ang = pos * invf, c = __cosf(ang), s = __sinf(ang);
                const float y = ((lane & 16) == 0) ? x * c - xp * s : x * c + xp * s;
                KRL[((size_t)((m - NCTX) >> 12) * 4608 + n) * 64 + lane] = (bf16_t)f2bf(y);
            }
        }
    }
}

template <bool H2>
__device__ __forceinline__ void ln_rows(const Params& p, const float* __restrict__ g, const float* __restrict__ b, unsigned char* lds, float* dst) {
    const int tid = threadIdx.x, lane = tid & 63, wave = tid >> 6;
    const float* mod = (const float*)(p.ws + OFF_MOD); bf16_t* Hb = (bf16_t*)(p.ws + OFF_R1);
    float* Lg = (float*)lds; float* Lb = Lg + DM; float* Ls = Lb + DM; float* Lh = Ls + DM;
    for (int ch = blockIdx.x; ch < MTOK / 64; ch += gridDim.x) {
        const int vv = (ch < 128) ? 0 : 1 + ((ch - 128) >> 6);
        const float* sh2 = mod + (size_t)vv * NMOD + 3 * DM; const float* sc2 = sh2 + DM;
        __syncthreads();
        { const int c = tid * 4; *(f32x4*)(Lg + c) = *(const f32x4*)(g + c); *(f32x4*)(Lb + c) = *(const f32x4*)(b + c);
          if constexpr (H2) { *(f32x4*)(Ls + c) = *(const f32x4*)(sc2 + c) + 1.f; *(f32x4*)(Lh + c) = *(const f32x4*)(sh2 + c); } }
        __syncthreads();
        const int m0 = ch * 64 + wave * 8;
        f32x4 nx[8];
#pragma unroll
        for (int j = 0; j < 8; ++j) nx[j] = *(const f32x4*)(p.out + (size_t)m0 * DM + j * 256 + lane * 4);
        for (int r = 0; r < 8; ++r) {
            const int m = m0 + r; const float* row = p.out + (size_t)m * DM; float* drow = dst + (size_t)m * DM;
            f32x4 v[8]; float s = 0.f;
#pragma unroll
            for (int j = 0; j < 8; ++j) { v[j] = nx[j]; s += (v[j].x + v[j].y) + (v[j].z + v[j].w); }
            if (r < 7) {
#pragma unroll
                for (int j = 0; j < 8; ++j) nx[j] = *(const f32x4*)(row + DM + j * 256 + lane * 4);
            }
            const float mean = wave_sum(s) * (1.f / DM); float s2 = 0.f;
#pragma unroll
            for (int j = 0; j < 8; ++j) { v[j] = v[j] - mean; s2 += (v[j].x * v[j].x + v[j].y * v[j].y) + (v[j].z * v[j].z + v[j].w * v[j].w); }
            const float rstd = rsqrtf(wave_sum(s2) * (1.f / DM) + LN_EPS);
#pragma unroll
            for (int j = 0; j < 8; ++j) { const int c = j * 256 + lane * 4;
                const f32x4 y = v[j] * rstd * *(const f32x4*)(Lg + c) + *(const f32x4*)(Lb + c);
                *(f32x4*)(drow + c) = y;
                if constexpr (H2) { const f32x4 h = y * *(const f32x4*)(Ls + c) + *(const f32x4*)(Lh + c);
                    u32x2 w; w.x = cvtpk(h.x, h.y); w.y = cvtpk(h.z, h.w); *(u32x2*)(Hb + (size_t)m * DM + c) = w; } }
        }
    }
}

__device__ __forceinline__ void late_weights(const Params& p, unsigned char* lds, int gw, int NGW) {
    const int tid = threadIdx.x, lane = tid & 63, wave = tid >> 6;
    LAS float* scr = (LAS float*)((LAS unsigned char*)lds + wave * 16384);
    constexpr int NB_GU = 2 * DFF / 32, IT_GU = (DM / 64) * NB_GU, IT_D = (DFF / 64) * (DM / 32);
    constexpr int IT_QB = (512 / 64) * (1536 / 32), IT_KVB = (512 / 64) * (2048 / 32), IT_O = (DM / 64) * (DM / 32);
    bf16_t* WGU = (bf16_t*)(p.ws + OFF_WGU); bf16_t* WD = (bf16_t*)(p.ws + OFF_WD);
    for (int it = gw; it < IT_QB + IT_KVB + IT_O; it += NGW) {
        int r = it;
        if (r < IT_QB) { transpose_plain(p.in[I_WQB], 512, 1536, (bf16_t*)(p.ws + OFF_WQB), r, scr, lane); continue; } r -= IT_QB;
        if (r < IT_KVB) { transpose_plain(p.in[I_WKVB], 512, 2048, (bf16_t*)(p.ws + OFF_WKVB), r, scr, lane); continue; } r -= IT_KVB;
        transpose_plain(p.in[I_WO], DM, DM, (bf16_t*)(p.ws + OFF_WO), r, scr, lane);
    }
    for (int it = gw; it < IT_GU + IT_D; it += NGW) {
        if (it < IT_GU) { const int kb = it / NB_GU, nb = it % NB_GU, n0 = nb * 32; const int j0 = (n0 < DFF) ? n0 : n0 - DFF;
            const int rowbase = (j0 >> 7) * 256 + ((n0 < DFF) ? 0 : 128) + (j0 & 127);
            transpose_item(p.in[I_WGU], DM, 2 * DFF, WGU, 64 * kb, n0, rowbase, scr, lane); }
        else transpose_plain(p.in[I_WDOWN], DFF, DM, WD, it - IT_GU, scr, lane);
    }
}

__device__ __forceinline__ void phase5(const Params& p, unsigned char* lds_, int modes = 15) {
    char* lds = (char*)lds_;
    const int G = gridDim.x, bx = blockIdx.x;
    const int vcu = (G % 8 == 0) ? (bx % 8) * (G / 8) + bx / 8 : bx;
    const bf16_t* Z = (const bf16_t*)(p.ws + OFF_Z); const bf16_t* Q = (const bf16_t*)(p.ws + OFF_Q); const bf16_t* KV = (const bf16_t*)(p.ws + OFF_KV);
    const bf16_t* CNK = (const bf16_t*)(p.ws + OFF_CNK); const bf16_t* CNV = (const bf16_t*)(p.ws + OFF_CNV);
    const bf16_t* KRL = (const bf16_t*)(p.ws + OFF_KRL);
    bf16_t* MIX = (bf16_t*)(p.ws + OFF_R1);
    if (modes & 8) for (int u = vcu; u < 256; u += G) { const int bh = u >> 4, qb = u & 15, b = bh >> 3, h = bh & 7;
        const size_t t0 = (size_t)NCTX + (size_t)b * 4096;
        const bf16_t* kv = KV + ((size_t)NCTX + (size_t)b * 4608) * 2048 + h * 256;
        att::Seg s0{kv, kv + 128, KRL + (size_t)b * 4608 * 64, 2048, 64};
        att::attn_unit<192, true, false>(Q + (t0 + qb * 256) * 1536 + h * 192, 1536, s0, 72, s0, 72, MIX + (t0 + qb * 256) * DM + 1024 + h * 128, lds, qb * 256, 0, nullptr); }
    if (modes & 4) for (int u = vcu; u < 256; u += G) { const int bh = u >> 4, qb = u & 15, b = bh >> 3, h = bh & 7;
        const size_t t0 = (size_t)NCTX + (size_t)b * 4096; const int r0 = qb * 4;
        const int kr0 = (r0 == 0) ? 0 : (r0 == 60 ? 56 : r0 - 4), NT0 = (r0 == 0 || r0 == 60) ? 8 : 11;
        att::Seg s0{Z + (t0 + kr0 * 64) * INCP + ZK + h * 128, Z + (t0 + kr0 * 64) * INCP + ZV + h * 128, nullptr, INCP, 0};
        att::Seg s1{CNK + (size_t)b * 512 * 1024 + h * 128, CNV + (size_t)b * 512 * 1024 + h * 128, nullptr, 1024, 0};
        att::attn_unit<128, true, true>(Z + (t0 + qb * 256) * INCP + ZQ + h * 128, INCP, s0, NT0, s1, NT0 + 8, MIX + (t0 + qb * 256) * DM + h * 128, lds, qb * 256, kr0, p.in[I_RPB] + h * 465); }
    if (modes & 2) for (int u = vcu; u < 256; u += G) { const int b = u >> 3, h = u & 7; const size_t t0 = (size_t)b * 256;
        att::Seg s0{KV + t0 * 2048 + h * 256, KV + t0 * 2048 + h * 256 + 128, Z + t0 * INCP + ZKR, 2048, INCP};
        att::attn_unit<192, false, true>(Q + t0 * 1536 + h * 192, 1536, s0, 4, s0, 4, MIX + t0 * DM + 1024 + h * 128, lds, 0, 0, nullptr); }
    if (modes & 1) for (int u = vcu; u < 256; u += G) { const int b = u >> 3, h = u & 7; const size_t t0 = (size_t)b * 256;
        att::Seg s0{Z + t0 * INCP + ZK + h * 128, Z + t0 * INCP + ZV + h * 128, nullptr, INCP, 0};
        att::attn_unit<128, false, true>(Z + t0 * INCP + ZQ + h * 128, INCP, s0, 4, s0, 4, MIX + t0 * DM + h * 128, lds, 0, 0, nullptr); }
}

#define XB_TMO      128
#define XB_XCNT(j)  (256  + 64 * (j))
#define XB_XSUB(j)  (1280 + 64 * (j))
#define XB_XGEN(j)  (2304 + 64 * (j))
#define XB_TOP      3328
#define XB_TOPGEN   3392
#define XCD_BAR_WORDS 3456
#define XB_SPIN_CAP (1u << 18)
__device__ __forceinline__ unsigned xb_ld(unsigned* p)              { return __hip_atomic_load(p, __ATOMIC_RELAXED, __HIP_MEMORY_SCOPE_AGENT); }
__device__ __forceinline__ unsigned xb_add(unsigned* p, unsigned v) { return __hip_atomic_fetch_add(p, v, __ATOMIC_RELAXED, __HIP_MEMORY_SCOPE_AGENT); }
__device__ __forceinline__ unsigned xb_xcc_id() { return (unsigned)__builtin_amdgcn_s_getreg((3 << 11) | 20) & 0xFu; }
#define XB_SPIN(cond, bar) do { unsigned _sp = 0; while (cond) { __builtin_amdgcn_s_sleep(1); \
    if ((++_sp & 255u) == 0u) { if (xb_ld(&(bar)[XB_TMO])) break; if (_sp > XB_SPIN_CAP) { atomicAdd(&(bar)[XB_TMO], 1u); break; } } } } while (0)
struct XcdBarrier { unsigned* bar; unsigned x; volatile LAS unsigned* st; };
__device__ __forceinline__ XcdBarrier xcd_barrier_post(unsigned* bar, volatile LAS unsigned* st) {
    XcdBarrier b; b.bar = bar; b.x = xb_xcc_id(); b.st = st;
    if (threadIdx.x == 0) (void)xb_add(&bar[XB_XCNT(b.x)], 1u);
    return b;
}
__device__ __forceinline__ void xcd_barrier_complete(unsigned* bar, unsigned x, unsigned& nloc, unsigned& nx) {
    const unsigned G = gridDim.x * gridDim.y * gridDim.z;
    unsigned sum, cnt, mine, sp = 0u;
    for (;;) {
        sum = 0u; cnt = 0u; mine = 0u;
#pragma unroll
        for (unsigned j = 0; j < 16; ++j) { const unsigned c = xb_ld(&bar[XB_XCNT(j)]); sum += c; cnt += (c > 0u) ? 1u : 0u; mine = (j == x) ? c : mine; }
        if (sum == G) break;
        __builtin_amdgcn_s_sleep(1);
        if ((++sp & 255u) == 0u) { if (xb_ld(&bar[XB_TMO])) break; if (sp > XB_SPIN_CAP) { atomicAdd(&bar[XB_TMO], 1u); break; } }
    }
    nloc = mine > 0u ? mine : 1u; nx = cnt > 0u ? cnt : 1u;
}
__device__ __forceinline__ void xcd_barrier(const XcdBarrier& b) {
    asm volatile("s_waitcnt vmcnt(0)" ::: "memory");
    __syncthreads();
    if (threadIdx.x == 0) {
        unsigned* bar = b.bar;
        __builtin_amdgcn_s_waitcnt(0);
        unsigned nloc = b.st[0], nx = b.st[1];
        if (nloc == 0u) { xcd_barrier_complete(bar, b.x, nloc, nx); b.st[0] = nloc; b.st[1] = nx; }
        const unsigned old = xb_add(&bar[XB_XSUB(b.x)], 1u);
        const unsigned gen = old / nloc;
        if (old + 1u == (gen + 1u) * nloc) {
            __builtin_amdgcn_fence(__ATOMIC_RELEASE, "agent");
            asm volatile("s_waitcnt vmcnt(0)" ::: "memory");
            const unsigned og = xb_add(&bar[XB_TOP], 1u);
            const unsigned tg = og / nx;
            if (og + 1u == (tg + 1u) * nx) xb_add(&bar[XB_TOPGEN], 1u);
            else XB_SPIN(xb_ld(&bar[XB_TOPGEN]) == tg, bar);
            __builtin_amdgcn_fence(__ATOMIC_ACQUIRE, "agent");
            xb_add(&bar[XB_XGEN(b.x)], 1u);
            asm volatile("s_waitcnt vmcnt(0)" ::: "memory");
        } else {
            XB_SPIN(xb_ld(&bar[XB_XGEN(b.x)]) == gen, bar);
            __builtin_amdgcn_fence(__ATOMIC_ACQUIRE, "agent");
            asm volatile("s_waitcnt vmcnt(0)" ::: "memory");
        }
    }
    __syncthreads();
}

__global__ void __launch_bounds__(NTHREADS, 2) mega_fwd(Params p) {
    extern __shared__ __attribute__((aligned(16))) unsigned char lds[];
    cg::grid_group grid = cg::this_grid();
    const int lo = p.ph_lo, hi = p.ph_hi, G = gridDim.x, bx = blockIdx.x;
    unsigned char* ws = p.ws;
    LAS unsigned char* ldsl = (LAS unsigned char*)lds;
#define IN(k) (lo <= (k) && (k) < hi)
#define SEAM(k) do { if (IN(k) && IN((k) + 1)) xcd_barrier(xbar); } while (0)
    volatile LAS unsigned* xst = (volatile LAS unsigned*)(ldsl + LDS_BYTES - 64);
    if (threadIdx.x == 0) { xst[0] = 0u; xst[1] = 0u; }
    unsigned* barw = (unsigned*)(ws + OFF_BAR);
    if (p.never) grid.sync();
    XcdBarrier xbar = xcd_barrier_post(barw, xst);
    if (IN(0)) phase0(p, lds);
    SEAM(0);
    if (IN(1)) { phase1_weights(p, lds); phase1(p); }
    SEAM(1);
    if (IN(2)) {
        pg8::Gemm g{(const bf16_t*)(ws + OFF_R1), (const bf16_t*)(ws + OFF_WIN), MTOK, INCP, DM, DM}; pg8::StaticOrder S; S.init(MTOK, INCP, G, bx);
        float* sK = p.out + (size_t)MTOK * DM; float* sV = sK + (size_t)NCTX * 1024; float* sKR = sV + (size_t)NCTX * 1024 + (size_t)NCTX * 512;
        pg8::EpiInProj E{(bf16_t*)(ws + OFF_Z), sK, sV, sKR};
        pg8::gemm_phase<false>(ldsl, g, S, E);
        if (PROBE_DUP == 2) pg8::gemm_phase<false>(ldsl, g, S, E);
        const int wave = threadIdx.x >> 6;
        if (G == 256) { if (bx >= 64) late_weights(p, lds, (bx - 64) * NWAVES + wave, 192 * NWAVES); }
        else late_weights(p, lds, bx * NWAVES + wave, G * NWAVES);
    }
    SEAM(2);
    if (IN(3)) phase3(p);
    SEAM(3);
    if (IN(4)) {
        pg8::Gemm g{(const bf16_t*)(ws + OFF_Z), (const bf16_t*)(ws + OFF_WKVB), MTOK, 2048, 512, INCP};
        pg8::P4Order S; S.so.init(MTOK, 14 * 256, G, bx); S.ws = (const char*)ws; S.G = G; S.c = bx;
        pg8::EpiP4 E{(bf16_t*)(ws + OFF_Q), (bf16_t*)(ws + OFF_KV)};
        pg8::gemm_phase<false>(ldsl, g, S, E);
    }
    SEAM(4);
    if (IN(5)) { phase5(p, lds); if (PROBE_DUP >= 50) phase5(p, lds, PROBE_DUP - 50); }
    SEAM(5);
    if (IN(6)) {
        pg8::Gemm g{(const bf16_t*)(ws + OFF_R1), (const bf16_t*)(ws + OFF_WO), MTOK, DM, DM, DM}; pg8::PanelOrder S{bx};
        pg8::EpiResidLN<true, false, true> E{p.in[I_XP], p.in[I_XS], nullptr, nullptr, (bf16_t*)(ws + OFF_X1B), (const float*)(ws + OFF_MOD) + 2 * DM, p.in[I_LN1G], p.in[I_LN1B],
                                (const float*)(ws + OFF_MOD) + 3 * DM, (bf16_t*)(ws + OFF_R1), (float*)(ws + OFF_STAT), (unsigned*)(ws + OFF_FLAG), ldsl + 131072};
        pg8::gemm_phase<true>(ldsl, g, S, E);
    }
    SEAM(6);
    if (IN(7)) {
        pg8::Gemm g{(const bf16_t*)(ws + OFF_R1), (const bf16_t*)(ws + OFF_WGU), MTOK, 2 * DFF, DM, DM}; pg8::StaticOrder S; S.init(MTOK, 2 * DFF, G, bx);
        pg8::EpiSwiGLU E{(bf16_t*)(ws + OFF_ACT)};
        pg8::gemm_phase<false>(ldsl, g, S, E);
        if (PROBE_DUP == 8) pg8::gemm_phase<false>(ldsl, g, S, E);
    }
    SEAM(7);
    if (IN(8)) {
        pg8::Gemm g{(const bf16_t*)(ws + OFF_ACT), (const bf16_t*)(ws + OFF_WD), MTOK, DM, DFF, DFF}; pg8::PanelOrder S{bx};
        pg8::EpiResidLN<false, true, false> E{nullptr, nullptr, (const bf16_t*)(ws + OFF_X1B), p.out, nullptr, (const float*)(ws + OFF_MOD) + 5 * DM, p.in[I_LN2G], p.in[I_LN2B], nullptr, nullptr,
                                 (float*)(ws + OFF_STAT) + (size_t)64 * 8 * 256 * 2, (unsigned*)(ws + OFF_FLAG) + 64, ldsl + 131072};
        pg8::gemm_phase<true>(ldsl, g, S, E);
    }
#undef IN
#undef SEAM
}

constexpr int NPHASE = 9;
extern "C" void kernel_launch(void* const* d_in, const int* in_sizes, int n_in, void* d_out, int out_size, void* d_ws, size_t ws_size, hipStream_t stream) {
    static int grid = 0;
    if (grid == 0) {
        if (n_in != 23 || ws_size < WS_NEED) { fprintf(stderr, "kernel_launch: expected 23 inputs and >= %zu bytes of workspace; got %d, %zu\n", (size_t)WS_NEED, n_in, ws_size); grid = -1; return; }
        int dev = 0, cus = 0, per_cu = 0;
        if (hipGetDevice(&dev) != hipSuccess || hipDeviceGetAttribute(&cus, hipDeviceAttributeMultiprocessorCount, dev) != hipSuccess) { grid = -1; return; }
        if (hipFuncSetAttribute((const void*)mega_fwd, hipFuncAttributeMaxDynamicSharedMemorySize, LDS_BYTES) != hipSuccess) { fprintf(stderr, "kernel_launch: hipFuncSetAttribute failed\n"); grid = -1; return; }
        if (hipOccupancyMaxActiveBlocksPerMultiprocessor(&per_cu, (const void*)mega_fwd, NTHREADS, LDS_BYTES) != hipSuccess || per_cu < 1) { fprintf(stderr, "kernel_launch: occupancy query gave %d\n", per_cu); grid = -1; return; }
        grid = cus * per_cu;
        if (grid > 256) grid = 256;
        if (grid != 256) { fprintf(stderr, "kernel_launch: this kernel needs a 256-workgroup co-resident grid (got %d)\n", grid); grid = -1; return; }
        fprintf(stderr, "kernel_launch: grid %d (cus %d x %d)\n", grid, cus, per_cu);
    }
    if (grid < 0) return;
    Params p{};
    for (int i = 0; i < 23; ++i) p.in[i] = (const float*)d_in[i];
    p.out = (float*)d_out; p.ws = (unsigned char*)d_ws;
    if (hipMemsetAsync((char*)d_ws + OFF_BAR, 0, CTL_BYTES, stream) != hipSuccess) { fprintf(stderr, "kernel_launch: memset failed\n"); return; }
#if MK_MULTI
    for (int k = 0; k < NPHASE; ++k) { p.ph_lo = k; p.ph_hi = k + 1; hipLaunchKernelGGL(mega_fwd, dim3(grid), dim3(NTHREADS), LDS_BYTES, stream, p); }
#else
    p.ph_lo = 0; p.ph_hi = NPHASE;
    void* args[] = {&p};
    hipError_t e = hipLaunchCooperativeKernel((const void*)mega_fwd, dim3(grid), dim3(NTHREADS), args, LDS_BYTES, stream);
    if (e != hipSuccess) fprintf(stderr, "kernel_launch: cooperative launch failed: %s (grid %d)\n", hipGetErrorString(e), grid);
#endif
}
```
